# Optimizing an MI355X kernel written in HIP

```python
import jax, jax.numpy as jnp
from jax import lax
import numpy as np

D_MODEL = 1024
BATCH = 16
SEQ = 2048
DEPTH = 2
DEC_BATCH = 8
DEC_SEQ = 32
PAST_LEN = 2048

CHUNK = 64
W_ATTN = D_MODEL // 4
W_CONV = D_MODEL // 4
W_GMLP = D_MODEL // 4
W_POOL = D_MODEL // 4
MIX_WIDTH = W_ATTN + W_CONV + W_GMLP + W_POOL
HEAD_DIM = 64
N_Q_HEADS = W_ATTN // HEAD_DIM
N_KV_HEADS = 2
Q_PER_KV = N_Q_HEADS // N_KV_HEADS
KV_WIDTH = N_KV_HEADS * HEAD_DIM
WINDOW = 128
WINDOW_CHUNKS = WINDOW // CHUNK
ROPE_THETA = 500000.0
ROT_DIM = HEAD_DIM // 4
CONV_WIDTH = 3
GMLP_CHUNK = 128
GMLP_GROUPS = 4
GMLP_GROUP_DIM = W_GMLP // GMLP_GROUPS
POOL_WINDOWS = (2, 4, 8, 16)
POOL_GROUP_DIM = W_POOL // len(POOL_WINDOWS)
POOL_HIST = max(POOL_WINDOWS) - 1
D_FF = 2816
FFN_CONV_WIDTH = 3
NORM_EPS = 1e-6
PROJ_WIDTH = W_ATTN + 2 * KV_WIDTH + 3 * W_CONV + 2 * W_GMLP + W_POOL

kernel_name = 'hybrid_streaming_encoder_step'


def split_points():
    sizes = (W_ATTN, KV_WIDTH, KV_WIDTH, W_CONV, W_CONV, W_CONV, W_GMLP, W_GMLP, W_POOL)
    pts, acc = [], 0
    for s in sizes[:-1]:
        acc += s
        pts.append(acc)
    return pts


def rmsnorm(x, g):
    xf = x.astype(jnp.float32)
    y = xf * lax.rsqrt(jnp.mean(xf * xf, axis=-1, keepdims=True) + NORM_EPS)
    return (y * g.astype(jnp.float32)).astype(x.dtype)


def layernorm(x, g, b):
    xf = x.astype(jnp.float32)
    mu = jnp.mean(xf, axis=-1, keepdims=True)
    var = jnp.mean(jnp.square(xf - mu), axis=-1, keepdims=True)
    y = (xf - mu) * lax.rsqrt(var + NORM_EPS) * g.astype(jnp.float32) + b.astype(jnp.float32)
    return y.astype(x.dtype)


def partial_rope(x, pos):
    half = ROT_DIM // 2
    inv_freq = jnp.power(jnp.float32(ROPE_THETA), -jnp.arange(half, dtype=jnp.float32) * (2.0 / ROT_DIM))
    ang = pos.astype(jnp.float32)[:, None] * inv_freq[None, :]
    cos = jnp.cos(ang)[None, :, None, :]
    sin = jnp.sin(ang)[None, :, None, :]
    xf = x.astype(jnp.float32)
    x1 = xf[..., :half]
    x2 = xf[..., half:ROT_DIM]
    out = jnp.concatenate([x1 * cos - x2 * sin, x2 * cos + x1 * sin, xf[..., ROT_DIM:]], axis=-1)
    return out.astype(x.dtype)


def sink_attention(q, k, v, sink, mask):
    s = jnp.einsum('...qkrd,...skd->...krqs', q, k).astype(jnp.float32) * (HEAD_DIM ** -0.5)
    if mask is not None:
        s = jnp.where(mask, s, -jnp.inf)
    sk = sink.astype(jnp.float32)[:, :, None, None]
    m = jnp.maximum(jnp.max(s, axis=-1, keepdims=True), sk)
    p = jnp.exp(s - m)
    w = p / (jnp.sum(p, axis=-1, keepdims=True) + jnp.exp(sk - m))
    return jnp.einsum('...krqs,...skd->...qkrd', w.astype(v.dtype), v)


def window_attention_prompt(q, k, v, sink):
    bsz, t_len = q.shape[:2]
    nc = t_len // CHUNK
    pad = WINDOW_CHUNKS * CHUNK
    kp = jnp.pad(k, ((0, 0), (pad, 0), (0, 0), (0, 0)))
    vp = jnp.pad(v, ((0, 0), (pad, 0), (0, 0), (0, 0)))
    band = [(j * CHUNK, j * CHUNK + t_len) for j in range(WINDOW_CHUNKS + 1)]
    kb = jnp.concatenate([kp[:, a:b].reshape(bsz, nc, CHUNK, N_KV_HEADS, HEAD_DIM) for a, b in band], axis=2)
    vb = jnp.concatenate([vp[:, a:b].reshape(bsz, nc, CHUNK, N_KV_HEADS, HEAD_DIM) for a, b in band], axis=2)
    key_pos = (jnp.arange(nc)[:, None] - WINDOW_CHUNKS) * CHUNK + jnp.arange((WINDOW_CHUNKS + 1) * CHUNK)[None, :]
    mask = (key_pos >= 0)[:, None, None, None, :]
    qb = q.reshape(bsz, nc, CHUNK, N_KV_HEADS, Q_PER_KV, HEAD_DIM)
    o = sink_attention(qb, kb, vb, sink.reshape(N_KV_HEADS, Q_PER_KV), mask)
    return o.reshape(bsz, t_len, W_ATTN)


def window_attention_sample(q, k, v, k_past, v_past, sink):
    bsz, t_len = q.shape[:2]
    kk = jnp.concatenate([k_past, k], axis=1)
    vv = jnp.concatenate([v_past, v], axis=1)
    qb = q.reshape(bsz, t_len, N_KV_HEADS, Q_PER_KV, HEAD_DIM)
    o = sink_attention(qb, kk, vv, sink.reshape(N_KV_HEADS, Q_PER_KV), None)
    return o.reshape(bsz, t_len, W_ATTN)


def causal_dwconv(x, past, w):
    width = w.shape[0]
    t_len = x.shape[1]
    ext = jnp.concatenate([past, x], axis=1)
    y = ext[:, 0:t_len] * w[0]
    for j in range(1, width):
        y = y + ext[:, j:j + t_len] * w[j]
    return y, ext[:, -(width - 1):]


def spatial_gating(u, v, ln_g, ln_b, w_s, b_s, first_chunk):
    u = jax.nn.gelu(u)
    v = layernorm(jax.nn.gelu(v), ln_g, ln_b)
    bsz, t_len, _ = v.shape
    ii = jnp.arange(GMLP_CHUNK)
    mask = (ii[None, :] // CHUNK) <= (ii[:, None] // CHUNK)
    wm = jnp.where(mask[None], w_s, jnp.zeros_like(w_s))
    if first_chunk:
        vb = v.reshape(bsz, t_len, GMLP_GROUPS, GMLP_GROUP_DIM)
        s = jnp.einsum('gij,bjgd->bigd', wm[:, :t_len, :t_len], vb) + b_s[:, :t_len].T[None, :, :, None]
    else:
        nc = t_len // GMLP_CHUNK
        vb = v.reshape(bsz, nc, GMLP_CHUNK, GMLP_GROUPS, GMLP_GROUP_DIM)
        s = jnp.einsum('gij,bcjgd->bcigd', wm, vb) + b_s.T[None, None, :, :, None]
    return u * s.reshape(bsz, t_len, W_GMLP), v


def multiscale_pool(p, past, pos0, w_pool, scale):
    bsz, t_len, _ = p.shape
    ext_in = jnp.concatenate([past, p], axis=1)
    ext = ext_in.astype(jnp.float32)
    cs = jnp.concatenate([jnp.zeros((bsz, 1, W_POOL), jnp.float32), jnp.cumsum(ext, axis=1)], axis=1)
    pos = pos0 + jnp.arange(t_len)
    outs = []
    for g, win in enumerate(POOL_WINDOWS):
        sl = slice(g * POOL_GROUP_DIM, (g + 1) * POOL_GROUP_DIM)
        wsum = cs[:, POOL_HIST + 1:POOL_HIST + 1 + t_len, sl] - cs[:, POOL_HIST + 1 - win:POOL_HIST + 1 - win + t_len, sl]
        cnt = jnp.minimum(pos + 1, win).astype(jnp.float32)[None, :, None]
        outs.append(wsum / cnt - ext[:, POOL_HIST:, sl])
    pooled = jnp.stack(outs, axis=2).astype(p.dtype)
    mixed = jnp.einsum('btgc,gcd->btgd', pooled, w_pool).reshape(bsz, t_len, W_POOL)
    return mixed * scale, ext_in[:, -POOL_HIST:]


def trunk_layer(x, lp, pos0, past):
    bsz, t_len, _ = x.shape
    h = rmsnorm(x, lp['g_mix'])
    z = h @ lp['w_in']
    q, k, v, c_b, c_c, c_h, g_u, g_v, p_in = jnp.split(z, split_points(), axis=-1)
    pos = pos0 + jnp.arange(t_len)
    q = partial_rope(q.reshape(bsz, t_len, N_Q_HEADS, HEAD_DIM), pos)
    k = partial_rope(k.reshape(bsz, t_len, N_KV_HEADS, HEAD_DIM), pos)
    v = v.reshape(bsz, t_len, N_KV_HEADS, HEAD_DIM)
    if past is None:
        o_attn = window_attention_prompt(q, k, v, lp['sink'])
        k_state, v_state = k[:, -WINDOW:], v[:, -WINDOW:]
        conv_past = jnp.zeros((bsz, CONV_WIDTH - 1, W_CONV), x.dtype)
        pool_past = jnp.zeros((bsz, POOL_HIST, W_POOL), x.dtype)
        ffn_past = jnp.zeros((bsz, FFN_CONV_WIDTH - 1, 2 * D_FF), x.dtype)
    else:
        k_past, v_past, conv_past, pool_past, ffn_past = past
        o_attn = window_attention_sample(q, k, v, k_past, v_past, lp['sink'])
        k_state, v_state = k, v
    zc, conv_state = causal_dwconv(c_c * c_h, conv_past, lp['conv_w'])
    o_conv = c_b * zc
    o_gmlp, gmlp_rows = spatial_gating(g_u, g_v, lp['gmlp_ln_g'], lp['gmlp_ln_b'], lp['gmlp_w'], lp['gmlp_b'], past is not None)
    o_pool, pool_state = multiscale_pool(p_in, pool_past, pos0, lp['pool_w'], lp['pool_scale'])
    x = x + jnp.concatenate([o_attn, o_conv, o_gmlp, o_pool], axis=-1) @ lp['w_out']
    up = rmsnorm(x, lp['g_ffn']) @ lp['w_up']
    up, ffn_state = causal_dwconv(up, ffn_past, lp['ffn_conv_w'])
    gate, val = jnp.split(up, 2, axis=-1)
    x = x + (jax.nn.silu(gate) * val) @ lp['w_down']
    return x, (k_state, v_state, conv_state, pool_state, ffn_state, gmlp_rows)


def setup_inputs(seed: int = 0) -> dict:
    key = jax.random.key(seed)
    ks = jax.random.split(key, 24)
    f32 = jnp.float32

    def nrm(k, shape, s):
        return jax.random.normal(k, shape, f32) * s

    return {
        'x_prompt': nrm(ks[0], (BATCH, SEQ, D_MODEL), 1.0),
        'x_sample': nrm(ks[1], (DEC_BATCH, DEC_SEQ, D_MODEL), 1.0),
        'cache_attn_k': nrm(ks[2], (DEC_BATCH, DEPTH, WINDOW, N_KV_HEADS, HEAD_DIM), 1.0),
        'cache_attn_v': nrm(ks[3], (DEC_BATCH, DEPTH, WINDOW, N_KV_HEADS, HEAD_DIM), 1.0),
        'state_conv': nrm(ks[4], (DEC_BATCH, DEPTH, CONV_WIDTH - 1, W_CONV), 1.0),
        'state_pool': nrm(ks[5], (DEC_BATCH, DEPTH, POOL_HIST, W_POOL), 1.0),
        'state_ffn_conv': nrm(ks[6], (DEC_BATCH, DEPTH, FFN_CONV_WIDTH - 1, 2 * D_FF), 1.0),
        'g_mix': 1.0 + nrm(ks[7], (DEPTH, D_MODEL), 0.01),
        'w_in': nrm(ks[8], (DEPTH, D_MODEL, PROJ_WIDTH), D_MODEL ** -0.5),
        'attn_sink': nrm(ks[9], (DEPTH, N_Q_HEADS), 0.5),
        'conv_w': nrm(ks[10], (DEPTH, CONV_WIDTH, W_CONV), CONV_WIDTH ** -0.5),
        'gmlp_ln_g': 1.0 + nrm(ks[11], (DEPTH, W_GMLP), 0.01),
        'gmlp_ln_b': nrm(ks[12], (DEPTH, W_GMLP), 0.01),
        'gmlp_w': nrm(ks[13], (DEPTH, GMLP_GROUPS, GMLP_CHUNK, GMLP_CHUNK), GMLP_CHUNK ** -0.5),
        'gmlp_b': nrm(ks[14], (DEPTH, GMLP_GROUPS, GMLP_CHUNK), 0.01),
        'pool_w': nrm(ks[15], (DEPTH, len(POOL_WINDOWS), POOL_GROUP_DIM, POOL_GROUP_DIM), POOL_GROUP_DIM ** -0.5),
        'pool_scale': 1.0 + nrm(ks[16], (DEPTH, W_POOL), 0.01),
        'w_out': nrm(ks[17], (DEPTH, MIX_WIDTH, D_MODEL), MIX_WIDTH ** -0.5),
        'g_ffn': 1.0 + nrm(ks[18], (DEPTH, D_MODEL), 0.01),
        'w_up': nrm(ks[19], (DEPTH, D_MODEL, 2 * D_FF), D_MODEL ** -0.5),
        'ffn_conv_w': nrm(ks[20], (DEPTH, FFN_CONV_WIDTH, 2 * D_FF), FFN_CONV_WIDTH ** -0.5),
        'w_down': nrm(ks[21], (DEPTH, D_FF, D_MODEL), D_FF ** -0.5),
        'g_final': 1.0 + nrm(ks[22], (D_MODEL,), 0.01),
    }


def reference(x_prompt, x_sample, cache_attn_k, cache_attn_v, state_conv, state_pool, state_ffn_conv,
              g_mix, w_in, attn_sink, conv_w, gmlp_ln_g, gmlp_ln_b, gmlp_w, gmlp_b, pool_w, pool_scale,
              w_out, g_ffn, w_up, ffn_conv_w, w_down, g_final):
    def run(x, pos0, pasts):
        per_layer = []
        for l in range(DEPTH):
            lp = {'g_mix': g_mix[l], 'w_in': w_in[l], 'sink': attn_sink[l], 'conv_w': conv_w[l],
                  'gmlp_ln_g': gmlp_ln_g[l], 'gmlp_ln_b': gmlp_ln_b[l], 'gmlp_w': gmlp_w[l], 'gmlp_b': gmlp_b[l],
                  'pool_w': pool_w[l], 'pool_scale': pool_scale[l], 'w_out': w_out[l], 'g_ffn': g_ffn[l],
                  'w_up': w_up[l], 'ffn_conv_w': ffn_conv_w[l], 'w_down': w_down[l]}
            past = None if pasts is None else tuple(a[:, l] for a in pasts)
            x, st = trunk_layer(x, lp, pos0, past)
            per_layer.append(st)
        states = [jnp.stack([st[i] for st in per_layer], axis=1) for i in range(6)]
        return rmsnorm(x, g_final), states

    y_prompt, sp = run(x_prompt, 0, None)
    y_sample, ss = run(x_sample, PAST_LEN, (cache_attn_k, cache_attn_v, state_conv, state_pool, state_ffn_conv))
    return (y_prompt, y_sample, sp[0], sp[1], sp[2], sp[3], sp[4], ss[0], ss[1], ss[2], ss[3], ss[4], ss[5])
```

```cpp
#include <hip/hip_runtime.h>
#include <cstdio>
#include <cstdint>

constexpr int DM = 1024, NB = 16, SEQ = 2048, MP = NB * SEQ, SB = 8, ST = 32, MS = SB * ST, MT = MP + MS;
constexpr int NPROJ = 2048, DFF = 2816, NUP = 2 * DFF, WIN = 128;
constexpr float EPS = 1e-6f;
constexpr int ZQ = 0, ZK = 256, ZV = 384, ZCB = 512, ZCC = 768, ZCH = 1024, ZGU = 1280, ZGV = 1536, ZPI = 1792;
constexpr size_t O_YP = 0, O_YS = 33554432, O_PK = 33816576, O_PV = 34340864, O_PC = 34865152, O_PP = 34881536, O_PF = 35004416,
                 O_SK = 35364864, O_SV = 35430400, O_SC = 35495936, O_SP = 35504128, O_SF = 35565568, O_SG = 35745792, O_END = 35876864;

__device__ __forceinline__ int lane_id() { int l; asm volatile("v_mbcnt_lo_u32_b32 %0, -1, 0\n\tv_mbcnt_hi_u32_b32 %0, -1, %0" : "=v"(l)); return l; }
namespace pg8 {
#define PG8_LAS __attribute__((address_space(3)))
typedef unsigned short bf16_t;
typedef short bf16x8 __attribute__((ext_vector_type(8)));
typedef float f32x4 __attribute__((ext_vector_type(4)));
typedef unsigned u32x4 __attribute__((ext_vector_type(4)));
constexpr int BM = 256, BK = 64, HALF = 128, HTB = HALF * BK * 2, STAGE_BYTES = 8 * HTB, NXCD = 8, WGM = 8;

__host__ __device__ __forceinline__ int lds_byte(int r, int c) { const int st = (r >> 4) * 2 + (c >> 5), rr = r & 15, cc = c & 31, ob = rr * 64 + cc * 2; return st * 1024 + (ob ^ (((ob >> 9) & 1) << 5)); }
__host__ __device__ __forceinline__ void stage_rc(int b, int& R, int& C) { const int st = b / 1024, sb = b % 1024, swz = sb ^ (((sb >> 9) & 1) << 5); R = (st >> 1) * 16 + swz / 64; C = (st & 1) * 32 + (swz % 64) / 2; }
__host__ __device__ __forceinline__ int perm32(int rho) { const int n = rho >> 4, i = rho & 15; return 8 * (i >> 2) + 4 * n + (i & 3); }

struct Unit { int pm, pn; };
struct Gemm { const bf16_t* A; const bf16_t* Bt; int M, N, K, lda; };

struct StaticOrder {
    int nM, nN, nwg, G, c;
    __host__ __device__ void init(int M, int N, int G_, int c_) { nM = M / BM; nN = N / BM; nwg = nM * nN; G = G_; c = c_; }
    __host__ __device__ bool next(int i, Unit& u) const {
        const long L = (long)i * G + c; if (L >= nwg) return false;
        int wgid = (int)L; { const int q = nwg / NXCD, r = nwg % NXCD, xcd = wgid % NXCD, off = wgid / NXCD; wgid = (xcd < r ? xcd * (q + 1) : r * (q + 1) + (xcd - r) * q) + off; }
        const int nig = WGM * nN, gid = wgid / nig, fm = gid * WGM, gsz = (nM - fm) < WGM ? (nM - fm) : WGM;
        u.pm = fm + ((wgid % nig) % gsz); u.pn = (wgid % nig) / gsz; return true;
    }
};

__device__ __forceinline__ unsigned cvt_pk_bf16(float lo, float hi) { unsigned r; asm volatile("v_cvt_pk_bf16_f32 %0, %1, %2" : "=v"(r) : "v"(lo), "v"(hi)); return r; }

template <class Epi, bool ALIGN_EPI, bool SP2>
__device__ __forceinline__ void gemm_phase(PG8_LAS unsigned char* lds, const Gemm g, const StaticOrder& S, const Epi& E, int wid_s) {
    const int lane = lane_id(); const int wid = wid_s, tid = wid * 64 + lane, wr = wid >> 2, wc = wid & 3, fr = lane & 15, fq = lane >> 4;
    const int K = g.K, nt = K / BK, lda = g.lda;
    unsigned voffA[2], voffB[2];
#pragma unroll
    for (int i = 0; i < 2; ++i) { int R, C; stage_rc(tid * 16 + i * 8192, R, C); const int Rb = Epi::PERM ? ((R & ~31) + perm32(R & 31)) : R;
        voffA[i] = (unsigned)((128 * (R >> 6) + (R & 63)) * lda + C) * 2u; voffB[i] = (unsigned)(Rb * K + C) * 2u; }
    const size_t kstep = (size_t)(BK * 2);
    const size_t hstepA = (size_t)64 * lda * 2, hstepB = (size_t)HALF * K * 2;
    const size_t tstepA = (size_t)BM * lda * 2, tstepB = 2 * hstepB;
    const unsigned ldsw = (unsigned)wid * 1024u;
    const int aoff = lds_byte(wr * 64 + fr, fq * 8), boff = lds_byte(wc * 32 + fr, fq * 8);
#define PG8_SA(b, h) (((b) * 2 + (h)) * HTB)
#define PG8_SB(b, h) ((4 + (b) * 2 + (h)) * HTB)
#define PG8_STAGE(bufoff, gbase, voff) do { _Pragma("unroll") for (int _i = 0; _i < 2; ++_i) \
        __builtin_amdgcn_global_load_lds((const unsigned*)((const char*)(gbase) + (voff)[_i]), (PG8_LAS unsigned*)(lds + (bufoff) + ldsw + _i * 8192), 16, 0, 0); } while (0)
#define PG8_LDA(dst, b, h) do { _Pragma("unroll") for (int m = 0; m < 4; ++m) _Pragma("unroll") for (int k = 0; k < 2; ++k) dst[m][k] = *(const PG8_LAS bf16x8*)(lds + PG8_SA(b, h) + aoff + m * 2048 + k * 1024); } while (0)
#define PG8_LDB(dst, b, h) do { _Pragma("unroll") for (int n = 0; n < 2; ++n) _Pragma("unroll") for (int k = 0; k < 2; ++k) dst[n][k] = *(const PG8_LAS bf16x8*)(lds + PG8_SB(b, h) + boff + n * 2048 + k * 1024); } while (0)
#define PG8_MMA(ai, bj, At, Bt) do { __builtin_amdgcn_s_setprio(1); _Pragma("unroll") for (int m = 0; m < 4; ++m) _Pragma("unroll") for (int n = 0; n < 2; ++n) _Pragma("unroll") for (int k = 0; k < 2; ++k) \
        acc[ai][bj][m][n] = __builtin_amdgcn_mfma_f32_16x16x32_bf16(Bt[n][k], At[m][k], acc[ai][bj][m][n], 0, 0, 0); __builtin_amdgcn_s_setprio(0); } while (0)
#define PG8_WAIT_V(n) asm volatile("s_waitcnt vmcnt(" #n ")" ::: "memory")
#define PG8_WAIT_L(n) asm volatile("s_waitcnt lgkmcnt(" #n ")" ::: "memory")
#define PG8_BAR __builtin_amdgcn_s_barrier()
#define PG8_SCHED __builtin_amdgcn_sched_barrier(0)
    Unit cur, nxt; int ui = 0;
    if (!S.next(0, cur)) return;
    f32x4 acc[2][2][4][2];
    typename Epi::InitT ini; E.init_load(ini, cur, wr, wc);
    bf16x8 At[4][2], B0[2][2], B1[2][2];
    const char* cA = (const char*)g.A + (size_t)cur.pm * tstepA; const char* cB = (const char*)g.Bt + (size_t)cur.pn * tstepB;
    E.prep(cur, 0, wid, lane);
    if constexpr (SP2) {
        PG8_STAGE(PG8_SB(0, 0), cB, voffB); PG8_STAGE(PG8_SB(0, 1), cB + hstepB, voffB); PG8_STAGE(PG8_SA(0, 0), cA, voffA); PG8_STAGE(PG8_SA(0, 1), cA + hstepA, voffA);
        if (wr == 1) PG8_BAR;
        PG8_WAIT_V(2); PG8_BAR;
        PG8_STAGE(PG8_SB(1, 0), cB + kstep, voffB); PG8_STAGE(PG8_SA(1, 0), cA + kstep, voffA); PG8_STAGE(PG8_SB(1, 1), cB + hstepB + kstep, voffB);
        PG8_WAIT_V(6); PG8_BAR;
    } else {
        PG8_STAGE(PG8_SB(0, 0), cB, voffB); PG8_STAGE(PG8_SA(0, 0), cA, voffA); PG8_STAGE(PG8_SB(0, 1), cB + hstepB, voffB); PG8_STAGE(PG8_SA(0, 1), cA + hstepA, voffA);
        if (wr == 1) PG8_BAR;
        PG8_WAIT_V(4); PG8_BAR;
        PG8_STAGE(PG8_SB(1, 0), cB + kstep, voffB); PG8_STAGE(PG8_SA(1, 0), cA + kstep, voffA); PG8_STAGE(PG8_SB(1, 1), cB + hstepB + kstep, voffB);
        PG8_WAIT_V(6); PG8_BAR;
    }
    E.init_finish(acc, ini);
    for (;;) {
        const bool has_next = S.next(ui + 1, nxt);
        const char* nA = has_next ? (const char*)g.A + (size_t)nxt.pm * tstepA : cA; const char* nB = has_next ? (const char*)g.Bt + (size_t)nxt.pn * tstepB : cB;
        for (int t = 0; t < nt; t += 2) {
            const bool last = (t == nt - 2);
            const char* a1 = cA + (size_t)(t + 1) * kstep;
            const char* a2 = last ? nA : cA + (size_t)(t + 2) * kstep; const char* b2 = last ? nB : cB + (size_t)(t + 2) * kstep;
            const char* a3 = a2 + kstep; const char* b3 = b2 + kstep;
            if (last && has_next) E.prep(nxt, ui + 1, wid, lane);
            if constexpr (SP2) {
            PG8_LDB(B0, 0, 0); PG8_LDB(B1, 0, 1); PG8_SCHED; PG8_LDA(At, 0, 0); PG8_STAGE(PG8_SA(1, 1), a1 + hstepA, voffA);
            PG8_WAIT_V(8); PG8_WAIT_L(0); PG8_BAR; PG8_MMA(0, 0, At, B0); PG8_MMA(0, 1, At, B1); PG8_BAR; PG8_SCHED;
            PG8_LDA(At, 0, 1); PG8_STAGE(PG8_SB(0, 0), b2, voffB); PG8_STAGE(PG8_SB(0, 1), b2 + hstepB, voffB); PG8_STAGE(PG8_SA(0, 0), a2, voffA);
            PG8_WAIT_V(8); PG8_WAIT_L(0); PG8_BAR; PG8_MMA(1, 0, At, B0); PG8_MMA(1, 1, At, B1); PG8_BAR; PG8_SCHED;
            PG8_LDB(B0, 1, 0); PG8_LDB(B1, 1, 1); PG8_SCHED; PG8_LDA(At, 1, 0); PG8_STAGE(PG8_SA(0, 1), a2 + hstepA, voffA);
            PG8_WAIT_V(8); PG8_WAIT_L(0); PG8_BAR; PG8_MMA(0, 0, At, B0); PG8_MMA(0, 1, At, B1); PG8_BAR; PG8_SCHED;
            PG8_LDA(At, 1, 1); PG8_STAGE(PG8_SB(1, 0), b3, voffB); PG8_STAGE(PG8_SB(1, 1), b3 + hstepB, voffB); PG8_STAGE(PG8_SA(1, 0), a3, voffA);
            PG8_WAIT_V(8); PG8_WAIT_L(0); PG8_BAR; PG8_MMA(1, 0, At, B0); PG8_MMA(1, 1, At, B1); PG8_BAR; PG8_SCHED;
            } else {
            PG8_LDB(B0, 0, 0); PG8_SCHED; PG8_LDA(At, 0, 0); PG8_STAGE(PG8_SA(1, 1), a1 + hstepA, voffA);
            PG8_WAIT_L(8); PG8_BAR; PG8_WAIT_L(0); PG8_MMA(0, 0, At, B0); PG8_BAR; PG8_SCHED;
            PG8_LDB(B1, 0, 1); PG8_STAGE(PG8_SB(0, 0), b2, voffB);
            PG8_BAR; PG8_WAIT_L(0); PG8_MMA(0, 1, At, B1); PG8_BAR;
            PG8_LDA(At, 0, 1); PG8_STAGE(PG8_SA(0, 0), a2, voffA);
            PG8_BAR; PG8_WAIT_L(0); PG8_MMA(1, 0, At, B0); PG8_BAR; PG8_SCHED;
            PG8_STAGE(PG8_SB(0, 1), b2 + hstepB, voffB);
            PG8_WAIT_V(6); PG8_BAR; PG8_MMA(1, 1, At, B1); PG8_BAR;
            PG8_LDB(B0, 1, 0); PG8_SCHED; PG8_LDA(At, 1, 0); PG8_STAGE(PG8_SA(0, 1), a2 + hstepA, voffA);
            PG8_WAIT_L(8); PG8_BAR; PG8_WAIT_L(0); PG8_MMA(0, 0, At, B0); PG8_BAR; PG8_SCHED;
            PG8_LDB(B1, 1, 1); PG8_STAGE(PG8_SB(1, 0), b3, voffB);
            PG8_BAR; PG8_WAIT_L(0); PG8_MMA(0, 1, At, B1); PG8_BAR;
            PG8_LDA(At, 1, 1); PG8_STAGE(PG8_SA(1, 0), a3, voffA);
            PG8_BAR; PG8_WAIT_L(0); PG8_MMA(1, 0, At, B0); PG8_BAR; PG8_SCHED;
            PG8_STAGE(PG8_SB(1, 1), b3 + hstepB, voffB);
            PG8_WAIT_V(6); PG8_BAR; PG8_MMA(1, 1, At, B1); PG8_BAR;
            }
        }
        if constexpr (ALIGN_EPI) { if (wr == 0) PG8_BAR; }
        E(acc, cur, ui, wr, wc, fr, fq);
        if (!has_next) break;
        E.init_load(ini, nxt, wr, wc); E.init_finish(acc, ini);
        cur = nxt; cA = nA; cB = nB; ++ui;
        if constexpr (ALIGN_EPI) { if (wr == 1) PG8_BAR; }
    }
    PG8_WAIT_V(0);
    if constexpr (!ALIGN_EPI) { if (wr == 0) PG8_BAR; }
    PG8_BAR;
#undef PG8_SA
#undef PG8_SB
#undef PG8_STAGE
#undef PG8_LDA
#undef PG8_LDB
#undef PG8_MMA
#undef PG8_WAIT_V
#undef PG8_WAIT_L
#undef PG8_BAR
#undef PG8_SCHED
}

struct ZeroInit {
    struct InitT {};
    __device__ __forceinline__ void init_load(InitT&, const Unit&, int, int) const {}
    __device__ __forceinline__ void init_finish(f32x4 (&acc)[2][2][4][2], const InitT&) const {
#pragma unroll
        for (int a = 0; a < 2; ++a)
#pragma unroll
            for (int b = 0; b < 2; ++b)
#pragma unroll
                for (int m = 0; m < 4; ++m)
#pragma unroll
                    for (int n = 0; n < 2; ++n) acc[a][b][m][n] = (f32x4){0.f, 0.f, 0.f, 0.f};
    }
};
struct ResidInit {
    struct InitT { u32x4 r[2][4][2]; };
    __device__ __forceinline__ void resid_load(InitT& it, const bf16_t* xin, const Unit& u, int wr, int wc) const {
        const int lane_ = lane_id(), fr = lane_ & 15, fq = lane_ >> 4; const int col0 = u.pn * BM + wc * 32 + 8 * fq;
#pragma unroll
        for (int ai = 0; ai < 2; ++ai)
#pragma unroll
            for (int m = 0; m < 4; ++m)
#pragma unroll
                for (int bj = 0; bj < 2; ++bj) it.r[ai][m][bj] = *(const u32x4*)(xin + (size_t)(u.pm * BM + wr * HALF + ai * 64 + m * 16 + fr) * DM + col0 + bj * HALF);
    }
    __device__ __forceinline__ void init_finish(f32x4 (&acc)[2][2][4][2], const InitT& it) const {
#pragma unroll
        for (int ai = 0; ai < 2; ++ai)
#pragma unroll
            for (int m = 0; m < 4; ++m)
#pragma unroll
                for (int bj = 0; bj < 2; ++bj) { const u32x4 r = it.r[ai][m][bj];
                    acc[ai][bj][m][0] = (f32x4){__builtin_bit_cast(float, r.x << 16), __builtin_bit_cast(float, r.x & 0xffff0000u), __builtin_bit_cast(float, r.y << 16), __builtin_bit_cast(float, r.y & 0xffff0000u)};
                    acc[ai][bj][m][1] = (f32x4){__builtin_bit_cast(float, r.z << 16), __builtin_bit_cast(float, r.z & 0xffff0000u), __builtin_bit_cast(float, r.w << 16), __builtin_bit_cast(float, r.w & 0xffff0000u)}; }
    }
};
template <int MODE> struct EpiRow : ZeroInit {
    static constexpr bool PERM = true;
    bf16_t* O; int ldc; const float* ssq; int nparts; PG8_LAS float* aux; const float* rope; PG8_LAS unsigned char* stg;
    __device__ __forceinline__ void prep(const Unit& u, int ui, int wid, int) const {
        const int lane = lane_id();
        if (wid < 4) {
#pragma unroll
            for (int p = 0; p < 4; ++p)
            __builtin_amdgcn_global_load_lds((const unsigned*)(ssq + (size_t)p * MT + u.pm * BM + wid * 64 + lane), (PG8_LAS unsigned*)(aux + ((ui & 1) * 4 + p) * 256 + wid * 64), 4, 0, 0); }
    }
    __device__ __forceinline__ void operator()(const f32x4 (&acc)[2][2][4][2], const Unit& u, int ui, int wr, int wc, int, int) const {
        const int lane_ = lane_id(), fr = lane_ & 15, fq = lane_ >> 4;
        const PG8_LAS float* ax = aux + (ui & 1) * 1024;
        PG8_LAS unsigned char* sw = stg + (wr * 4 + wc) * 1280 + fr * 80 + fq * 16; const PG8_LAS unsigned char* sr = stg + (wr * 4 + wc) * 1280 + (lane_ >> 2) * 80 + (lane_ & 3) * 16;
#pragma unroll
        for (int ai = 0; ai < 2; ++ai)
#pragma unroll
            for (int m = 0; m < 4; ++m) {
                const int rl = wr * HALF + ai * 64 + m * 16 + fr; const int row = u.pm * BM + rl; const float ssum = (ax[rl] + ax[256 + rl]) + (ax[512 + rl] + ax[768 + rl]); const float rs = __builtin_amdgcn_rsqf(ssum * (1.0f / DM) + EPS);
                bf16_t* rowp = O + (size_t)(u.pm * BM + wr * HALF + ai * 64 + m * 16 + (lane_ >> 2)) * ldc + u.pn * BM + wc * 32 + 8 * (lane_ & 3);
                f32x4 cs[4];
                const bool dorope = (MODE == 1) && (u.pn <= 1) && ((wc & 1) == 0);
                if (MODE == 1) { if (dorope && fq < 2) { const int pos = row < MP ? (row & (SEQ - 1)) : (SEQ + ((row - MP) & (ST - 1))); const f32x4* rp = (const f32x4*)(rope + (size_t)pos * 16);
                    cs[0] = rp[0]; cs[1] = rp[1]; cs[2] = rp[2]; cs[3] = rp[3]; } else { cs[0] = cs[1] = cs[2] = cs[3] = (f32x4){1.f, 0.f, 1.f, 0.f}; } }
#pragma unroll
                for (int bj = 0; bj < 2; ++bj) {
                    f32x4 v0 = acc[ai][bj][m][0] * rs, v1 = acc[ai][bj][m][1] * rs;
                    if (MODE == 1) { if (dorope && (u.pn == 0 || bj == 0)) {
                        f32x4 o0, o1;
#pragma unroll
                        for (int e = 0; e < 4; ++e) { o0[e] = __shfl_xor(v0[e], 16); o1[e] = __shfl_xor(v1[e], 16); }
                        if (fq < 2) { const float sg = fq == 0 ? -1.f : 1.f;
                            v0 = (f32x4){v0[0] * cs[0][0] + sg * o0[0] * cs[0][1], v0[1] * cs[0][2] + sg * o0[1] * cs[0][3], v0[2] * cs[1][0] + sg * o0[2] * cs[1][1], v0[3] * cs[1][2] + sg * o0[3] * cs[1][3]};
                            v1 = (f32x4){v1[0] * cs[2][0] + sg * o1[0] * cs[2][1], v1[1] * cs[2][2] + sg * o1[1] * cs[2][3], v1[2] * cs[3][0] + sg * o1[2] * cs[3][1], v1[3] * cs[3][2] + sg * o1[3] * cs[3][3]}; }
                    } }
                    u32x4 w; w.x = cvt_pk_bf16(v0[0], v0[1]); w.y = cvt_pk_bf16(v0[2], v0[3]); w.z = cvt_pk_bf16(v1[0], v1[1]); w.w = cvt_pk_bf16(v1[2], v1[3]);
                    *(PG8_LAS u32x4*)sw = w; const u32x4 w2 = *(const PG8_LAS u32x4*)sr; *(u32x4*)(rowp + bj * HALF) = w2;
                }
            }
    }
};
__device__ __forceinline__ float dpp_ror1(float v) { return __builtin_bit_cast(float, __builtin_amdgcn_mov_dpp(__builtin_bit_cast(int, v), 0x121, 0xf, 0xf, true)); }
__device__ __forceinline__ float dpp_ror2(float v) { return __builtin_bit_cast(float, __builtin_amdgcn_mov_dpp(__builtin_bit_cast(int, v), 0x122, 0xf, 0xf, true)); }
struct EpiUpAct : ZeroInit {
    static constexpr bool PERM = true;
    bf16_t* act; const float* ssq; int nparts; PG8_LAS float* aux; PG8_LAS f32x4* xch; PG8_LAS float* wl; const float* fcw; float* head; float* tail; float* fout;
    __device__ __forceinline__ void prep(const Unit& u, int ui, int wid, int) const {
        const int lane = lane_id();
        if (wid < 4) {
#pragma unroll
            for (int p = 0; p < 4; ++p)
            __builtin_amdgcn_global_load_lds((const unsigned*)(ssq + (size_t)p * MT + u.pm * BM + wid * 64 + lane), (PG8_LAS unsigned*)(aux + ((ui & 1) * 4 + p) * 256 + wid * 64), 4, 0, 0); }
        else {
#pragma unroll
            for (int k = 0; k < 3; ++k) { const int c = (wid - 4) * 3 + k, j = c >> 2, bj = (c >> 1) & 1, hf = c & 1;
                __builtin_amdgcn_global_load_lds((const unsigned*)(fcw + (size_t)j * NUP + bj * DFF + u.pn * HALF + hf * 64 + lane), (PG8_LAS unsigned*)(wl + (ui & 1) * 768 + c * 64), 4, 0, 0); } }
    }
    __device__ __forceinline__ void operator()(const f32x4 (&acc)[2][2][4][2], const Unit& u, int ui, int wr, int wc, int, int) const {
        const int lane_ = lane_id(), fr = lane_ & 15, fq = lane_ >> 4;
        const PG8_LAS float* ax = aux + (ui & 1) * 1024; const PG8_LAS float* wq = wl + (ui & 1) * 768;
        float rs[2][4];
#pragma unroll
        for (int ai = 0; ai < 2; ++ai)
#pragma unroll
            for (int m = 0; m < 4; ++m) { const int rl = wr * HALF + ai * 64 + m * 16 + fr; const float ssum = (ax[rl] + ax[256 + rl]) + (ax[512 + rl] + ax[768 + rl]); rs[ai][m] = __builtin_amdgcn_rsqf(ssum * (1.0f / DM) + EPS); }
        const int cl = wc * 32 + 8 * fq;
        if (fr >= 14) {
#pragma unroll
            for (int bj = 0; bj < 2; ++bj)
#pragma unroll
                for (int n = 0; n < 2; ++n) { const f32x4 x = acc[1][bj][3][n] * rs[1][3];
                    if (wr == 0) xch[((bj * 4 + wc) * 2 + n) * 8 + fq * 2 + (fr - 14)] = x;
                    else { *(f32x4*)(tail + (size_t)(u.pm * 2 + (fr - 14)) * NUP + u.pn * BM + bj * HALF + cl + 4 * n) = x;
                        if ((u.pm & 7) == 7) *(f32x4*)(fout + (size_t)((u.pm >> 3) * 4 + (fr - 14)) * NUP + bj * DFF + u.pn * HALF + cl + 4 * n) = x; } }
        }
        if (fr < 2 && wr == 0) {
#pragma unroll
            for (int bj = 0; bj < 2; ++bj)
#pragma unroll
                for (int n = 0; n < 2; ++n) *(f32x4*)(head + (size_t)(u.pm * 2 + fr) * NUP + u.pn * BM + bj * HALF + cl + 4 * n) = acc[0][bj][0][n] * rs[0][0];
        }
        asm volatile("s_waitcnt lgkmcnt(0)" ::: "memory"); __builtin_amdgcn_s_barrier(); asm volatile("" ::: "memory");
        const bool f1 = fr >= 1, f2 = fr >= 2;
        bf16_t* arow = act + (size_t)(u.pm * BM + wr * HALF + fr) * DFF + u.pn * HALF + cl;
        unsigned pk0[8][2];
#pragma unroll
        for (int n = 0; n < 2; ++n) {
            f32x4 wg[3], wv[3];
#pragma unroll
            for (int j = 0; j < 3; ++j) { wg[j] = *(const PG8_LAS f32x4*)(wq + (j * 2 + 0) * 128 + cl + 4 * n); wv[j] = *(const PG8_LAS f32x4*)(wq + (j * 2 + 1) * 128 + cl + 4 * n); }
            f32x4 hg = (f32x4){0.f, 0.f, 0.f, 0.f}, hv = hg;
            if (wr == 1 && fr >= 14) { hg = xch[((0 * 4 + wc) * 2 + n) * 8 + fq * 2 + (fr - 14)]; hv = xch[((1 * 4 + wc) * 2 + n) * 8 + fq * 2 + (fr - 14)]; }
            f32x4 r1g, r2g, r1v, r2v;
#pragma unroll
            for (int e = 0; e < 4; ++e) { r1g[e] = dpp_ror1(hg[e]); r2g[e] = dpp_ror2(hg[e]); r1v[e] = dpp_ror1(hv[e]); r2v[e] = dpp_ror2(hv[e]); }
#pragma unroll
            for (int blk = 0; blk < 8; ++blk) {
                const int ai = blk >> 2, m = blk & 3;
                const f32x4 xg = acc[ai][0][m][n] * rs[ai][m], xv = acc[ai][1][m][n] * rs[ai][m];
                f32x4 a;
#pragma unroll
                for (int e = 0; e < 4; ++e) {
                    const float c1g = dpp_ror1(xg[e]), c2g = dpp_ror2(xg[e]), c1v = dpp_ror1(xv[e]), c2v = dpp_ror2(xv[e]);
                    const float yg = wg[2][e] * xg[e] + wg[1][e] * (f1 ? c1g : r1g[e]) + wg[0][e] * (f2 ? c2g : r2g[e]);
                    const float yv = wv[2][e] * xv[e] + wv[1][e] * (f1 ? c1v : r1v[e]) + wv[0][e] * (f2 ? c2v : r2v[e]);
                    a[e] = yg * __builtin_amdgcn_rcpf(1.f + __builtin_amdgcn_exp2f(-1.4426950408889634f * yg)) * yv;
                    r1g[e] = c1g; r2g[e] = c2g; r1v[e] = c1v; r2v[e] = c2v;
                }
                if (n == 0) { pk0[blk][0] = cvt_pk_bf16(a[0], a[1]); pk0[blk][1] = cvt_pk_bf16(a[2], a[3]); }
                else { u32x4 w; w.x = pk0[blk][0]; w.y = pk0[blk][1]; w.z = cvt_pk_bf16(a[0], a[1]); w.w = cvt_pk_bf16(a[2], a[3]);
                    { bf16_t* sp_ = arow + (size_t)blk * 16 * DFF; asm volatile("global_store_dwordx4 %0, %1, off nt sc1\n\ts_nop 1" :: "v"(sp_), "v"(w) : "memory"); } }
            }
        }
    }
};
struct EpiRes : ResidInit {
    static constexpr bool PERM = true;
    const bf16_t* xin; bf16_t* xout; float* ssq_out; PG8_LAS float* red;
    __device__ __forceinline__ void prep(const Unit&, int, int, int) const {}
    __device__ __forceinline__ void init_load(InitT& it, const Unit& u, int wr, int wc) const { resid_load(it, xin, u, wr, wc); }
    __device__ __forceinline__ void operator()(const f32x4 (&acc)[2][2][4][2], const Unit& u, int ui, int wr, int wc, int, int) const {
        const int lane_ = lane_id(), fr = lane_ & 15, fq = lane_ >> 4;
        const int col0 = u.pn * BM + wc * 32 + 8 * fq;
#pragma unroll
        for (int ai = 0; ai < 2; ++ai) {
            const int rl0 = wr * HALF + ai * 64 + fr; const size_t off0 = (size_t)(u.pm * BM + rl0) * DM + col0;
#pragma unroll
            for (int m = 0; m < 4; ++m) {
                float sq = 0.f;
#pragma unroll
                for (int bj = 0; bj < 2; ++bj) {
                    const f32x4 v0 = acc[ai][bj][m][0], v1 = acc[ai][bj][m][1];
                    u32x4 w; w.x = cvt_pk_bf16(v0[0], v0[1]); w.y = cvt_pk_bf16(v0[2], v0[3]); w.z = cvt_pk_bf16(v1[0], v1[1]); w.w = cvt_pk_bf16(v1[2], v1[3]);
                    *(u32x4*)(xout + off0 + (size_t)m * 16 * DM + bj * HALF) = w;
                    const float q0 = __builtin_bit_cast(float, w.x << 16), q1 = __builtin_bit_cast(float, w.x & 0xffff0000u), q2 = __builtin_bit_cast(float, w.y << 16), q3 = __builtin_bit_cast(float, w.y & 0xffff0000u);
                    const float q4 = __builtin_bit_cast(float, w.z << 16), q5 = __builtin_bit_cast(float, w.z & 0xffff0000u), q6 = __builtin_bit_cast(float, w.w << 16), q7 = __builtin_bit_cast(float, w.w & 0xffff0000u);
                    sq += (q0 * q0 + q1 * q1) + (q2 * q2 + q3 * q3) + (q4 * q4 + q5 * q5) + (q6 * q6 + q7 * q7);
                }
                sq += __shfl_xor(sq, 16); sq += __shfl_xor(sq, 32);
                if (fq == 0) red[wc * 256 + rl0 + m * 16] = sq;
            }
        }
        asm volatile("s_waitcnt lgkmcnt(0)" ::: "memory"); __builtin_amdgcn_s_barrier(); asm volatile("" ::: "memory");
        if (wr == 0) { const int t = wc * 64 + lane_; ssq_out[(size_t)u.pn * MT + u.pm * BM + t] = (red[t] + red[256 + t]) + (red[512 + t] + red[768 + t]); }
    }
};
struct EpiFinal : ResidInit {
    static constexpr bool PERM = true;
    const bf16_t* xin; float* yout; const float* gfin; float* xbuf; unsigned* cnt; PG8_LAS float* red;
    __device__ __forceinline__ void prep(const Unit&, int, int, int) const {}
    __device__ __forceinline__ void init_load(InitT& it, const Unit& u, int wr, int wc) const { resid_load(it, xin, u, wr, wc); }
    __device__ __forceinline__ void operator()(const f32x4 (&acc)[2][2][4][2], const Unit& u, int ui, int wr, int wc, int, int) const {
        const int lane_ = lane_id(), fr = lane_ & 15, fq = lane_ >> 4;
        const int col0 = u.pn * BM + wc * 32 + 8 * fq;
        f32x4 gv[2][2];
#pragma unroll
        for (int bj = 0; bj < 2; ++bj) { gv[bj][0] = *(const f32x4*)(gfin + col0 + bj * HALF); gv[bj][1] = *(const f32x4*)(gfin + col0 + bj * HALF + 4); }
#define EF_X(ai, m, bj, v0, v1) const f32x4 v0 = acc[ai][bj][m][0], v1 = acc[ai][bj][m][1];
#pragma unroll
        for (int ai = 0; ai < 2; ++ai)
#pragma unroll
            for (int m = 0; m < 4; ++m) { float sq = 0.f;
#pragma unroll
                for (int bj = 0; bj < 2; ++bj) { EF_X(ai, m, bj, v0, v1)
                    sq += (v0[0] * v0[0] + v0[1] * v0[1]) + (v0[2] * v0[2] + v0[3] * v0[3]) + (v1[0] * v1[0] + v1[1] * v1[1]) + (v1[2] * v1[2] + v1[3] * v1[3]); }
                sq += __shfl_xor(sq, 16); sq += __shfl_xor(sq, 32);
                if (fq == 0) red[wc * 256 + wr * HALF + ai * 64 + m * 16 + fr] = sq; }
        asm volatile("s_waitcnt lgkmcnt(0)" ::: "memory"); __builtin_amdgcn_s_barrier(); asm volatile("" ::: "memory");
        const int t = wc * 64 + lane_;
        if (wr == 0) {
            const float sp = (red[t] + red[256 + t]) + (red[512 + t] + red[768 + t]);
            __hip_atomic_store(xbuf + (size_t)(u.pm * BM + t) * 4 + u.pn, sp, __ATOMIC_RELAXED, __HIP_MEMORY_SCOPE_AGENT);
            asm volatile("s_waitcnt vmcnt(0)" ::: "memory");
            if (lane_ == 0) __hip_atomic_fetch_add(cnt + 64 * u.pm, 1u, __ATOMIC_RELAXED, __HIP_MEMORY_SCOPE_AGENT);
            if (wc == 0) {
                unsigned spins = 0;
                while ((unsigned)__builtin_amdgcn_readfirstlane(__hip_atomic_load(cnt + 64 * u.pm, __ATOMIC_RELAXED, __HIP_MEMORY_SCOPE_AGENT)) < 16u) { __builtin_amdgcn_s_sleep(2); if (++spins > (1u << 22)) break; }
                __builtin_amdgcn_fence(__ATOMIC_ACQUIRE, "agent");
            }
        }
        asm volatile("s_waitcnt vmcnt(0) lgkmcnt(0)" ::: "memory"); __builtin_amdgcn_s_barrier(); asm volatile("" ::: "memory");
        if (wr == 0) {
            const float* sl = xbuf + (size_t)(u.pm * BM + t) * 4;
            const float tot = (__hip_atomic_load(sl, __ATOMIC_RELAXED, __HIP_MEMORY_SCOPE_AGENT) + __hip_atomic_load(sl + 1, __ATOMIC_RELAXED, __HIP_MEMORY_SCOPE_AGENT))
                            + (__hip_atomic_load(sl + 2, __ATOMIC_RELAXED, __HIP_MEMORY_SCOPE_AGENT) + __hip_atomic_load(sl + 3, __ATOMIC_RELAXED, __HIP_MEMORY_SCOPE_AGENT));
            red[t] = __builtin_amdgcn_rsqf(tot * (1.0f / DM) + EPS);
        }
        asm volatile("s_waitcnt lgkmcnt(0)" ::: "memory"); __builtin_amdgcn_s_barrier(); asm volatile("" ::: "memory");
#pragma unroll
        for (int ai = 0; ai < 2; ++ai)
#pragma unroll
            for (int m = 0; m < 4; ++m) { const int rl = wr * HALF + ai * 64 + m * 16 + fr; const float rs = red[rl];
                float* dst = yout + (size_t)(u.pm * BM + rl) * DM + col0;
#pragma unroll
                for (int bj = 0; bj < 2; ++bj) { EF_X(ai, m, bj, v0, v1)
                    *(f32x4*)(dst + bj * HALF) = v0 * rs * gv[bj][0]; *(f32x4*)(dst + bj * HALF + 4) = v1 * rs * gv[bj][1]; } }
#undef EF_X
    }
};
}

constexpr size_t MiB = 1u << 20;
constexpr size_t WS_CTL = 0, CTL_ZERO_BYTES = 1 * MiB;
constexpr size_t WS_ROPE = 1 * MiB;
constexpr size_t WS_WIN = 2 * MiB, WS_WOUT = 10 * MiB, WS_WUP = 14 * MiB, WS_WDN = 36 * MiB;
constexpr size_t WS_SSQA = 47 * MiB, WS_SSQB = 50 * MiB;
constexpr size_t WS_HEAD = 53 * MiB, WS_TAIL = 59 * MiB;
constexpr size_t WS_XB = 65 * MiB;
constexpr size_t WS_Z = 130 * MiB;
constexpr size_t WS_MIX = 260 * MiB;
constexpr size_t WS_ACT = 130 * MiB;
constexpr size_t WS_UPS = 488 * MiB;
constexpr size_t WS_END = 492 * MiB;
static_assert(WS_ACT + (size_t)MT * DFF * 2 <= WS_UPS && WS_UPS + (size_t)MS * NUP * 2 <= WS_END && WS_MIX + (size_t)MT * DM * 2 <= WS_END && WS_Z + (size_t)MT * NPROJ * 2 <= WS_MIX && WS_XB + (size_t)MT * DM * 2 <= WS_Z, "ws map");
static_assert(WS_HEAD + (size_t)128 * 2 * NUP * 4 <= WS_TAIL && WS_TAIL + (size_t)128 * 2 * NUP * 4 <= WS_XB && WS_SSQA + (size_t)16 * MT * 4 <= WS_SSQB && WS_SSQB + (size_t)16 * MT * 4 <= WS_TAIL, "ws map 2");
constexpr int CW_TMO = 0, CW_BAR = 4096, CW_PANEL = 16384;

constexpr int RING_BYTES = 131072;
constexpr int AUX_OFF = RING_BYTES;
constexpr int LDS_BYTES = 163840;
constexpr int MISC_OFF = LDS_BYTES - 128;

#define GAS __attribute__((address_space(1)))
#define LAS __attribute__((address_space(3)))
typedef unsigned short bf16;
typedef unsigned v4u __attribute__((ext_vector_type(4), may_alias));
typedef unsigned v2u __attribute__((ext_vector_type(2), may_alias));
typedef float f32x4 __attribute__((ext_vector_type(4)));
#define LDS_WAIT() asm volatile("s_waitcnt lgkmcnt(0)" ::: "memory")
__device__ __forceinline__ unsigned f2bf(float f) { unsigned u = __builtin_bit_cast(unsigned, f); return (u + 0x7fffu + ((u >> 16) & 1u)) >> 16; }
__device__ __forceinline__ unsigned pk2(float lo, float hi) { return f2bf(lo) | (f2bf(hi) << 16); }
__device__ __forceinline__ float bf2f(unsigned h) { return __builtin_bit_cast(float, h << 16); }
__device__ __forceinline__ float bflo(unsigned w) { return __builtin_bit_cast(float, w << 16); }
__device__ __forceinline__ float bfhi(unsigned w) { return __builtin_bit_cast(float, w & 0xffff0000u); }
__device__ __forceinline__ float gelu_t(float x) { const float y2 = 2.302208198f * (x + 0.044715f * x * x * x);     const float e = __builtin_amdgcn_exp2f(y2); return x * (1.f - __builtin_amdgcn_rcpf(e + 1.f)); }
__device__ __forceinline__ float silu_f(float x) { return x * __builtin_amdgcn_rcpf(1.f + __builtin_amdgcn_exp2f(-1.4426950408889634f * x)); }
__device__ __forceinline__ float wave_sum(float v) {
#pragma unroll
    for (int o = 1; o < 64; o <<= 1) v += __shfl_xor(v, o);
    return v;
}

#define XB_TMO      128
#define XB_XCNT(j)  (256  + 64 * (j))
#define XB_XSUB(j)  (1280 + 64 * (j))
#define XB_XGEN(j)  (2304 + 64 * (j))
#define XB_TOP      3328
#define XB_TOPGEN   3392
#define XCD_BAR_WORDS 3456
#define XB_SPIN_CAP (1u << 18)
__device__ __forceinline__ unsigned xb_ld(unsigned* p)              { return __hip_atomic_load(p, __ATOMIC_RELAXED, __HIP_MEMORY_SCOPE_AGENT); }
__device__ __forceinline__ unsigned xb_add(unsigned* p, unsigned v) { return __hip_atomic_fetch_add(p, v, __ATOMIC_RELAXED, __HIP_MEMORY_SCOPE_AGENT); }
__device__ __forceinline__ unsigned xb_xcc_id() { return (unsigned)__builtin_amdgcn_s_getreg((3 << 11) | 20) & 0xFu; }
#define XB_SPIN(cond, bar) do { unsigned _sp = 0; while (cond) { __builtin_amdgcn_s_sleep(1); \
    if ((++_sp & 255u) == 0u) { if (xb_ld(&(bar)[XB_TMO])) break; if (_sp > XB_SPIN_CAP) { atomicAdd(&(bar)[XB_TMO], 1u); break; } } } } while (0)
struct XcdBarrier { unsigned* bar; unsigned x; volatile LAS unsigned* st; };
__device__ __forceinline__ XcdBarrier xcd_barrier_post(unsigned* bar, volatile LAS unsigned* st) {
    XcdBarrier b; b.bar = bar; b.x = xb_xcc_id(); b.st = st;
    if (threadIdx.x == 0) (void)xb_add(&bar[XB_XCNT(b.x)], 1u);
    return b;
}
__device__ __forceinline__ void xcd_barrier_complete(unsigned* bar, unsigned x, unsigned& nloc, unsigned& nx) {
    const unsigned G = gridDim.x * gridDim.y * gridDim.z;
    unsigned sum, cnt, mine, sp = 0u;
    for (;;) {
        sum = 0u; cnt = 0u; mine = 0u;
#pragma unroll
        for (unsigned j = 0; j < 16; ++j) { const unsigned c = xb_ld(&bar[XB_XCNT(j)]); sum += c; cnt += (c > 0u) ? 1u : 0u; mine = (j == x) ? c : mine; }
        if (sum == G) break;
        __builtin_amdgcn_s_sleep(1);
        if ((++sp & 255u) == 0u) { if (xb_ld(&bar[XB_TMO])) break; if (sp > XB_SPIN_CAP) { atomicAdd(&bar[XB_TMO], 1u); break; } }
    }
    nloc = mine > 0u ? mine : 1u; nx = cnt > 0u ? cnt : 1u;
}
__device__ __forceinline__ void xcd_barrier(const XcdBarrier& b, int wave) {
    asm volatile("s_waitcnt vmcnt(0)" ::: "memory");
    __syncthreads();
    if (wave == 0 && lane_id() == 0) {
        unsigned* bar = b.bar;
        __builtin_amdgcn_s_waitcnt(0);
        unsigned nloc = b.st[0], nx = b.st[1];
        if (nloc == 0u) { xcd_barrier_complete(bar, b.x, nloc, nx); b.st[0] = nloc; b.st[1] = nx; }
        const unsigned old = xb_add(&bar[XB_XSUB(b.x)], 1u);
        const unsigned gen = old / nloc;
        if (old + 1u == (gen + 1u) * nloc) {
            __builtin_amdgcn_fence(__ATOMIC_RELEASE, "agent");
            asm volatile("s_waitcnt vmcnt(0)" ::: "memory");
            const unsigned og = xb_add(&bar[XB_TOP], 1u);
            const unsigned tg = og / nx;
            if (og + 1u == (tg + 1u) * nx) xb_add(&bar[XB_TOPGEN], 1u);
            else XB_SPIN(xb_ld(&bar[XB_TOPGEN]) == tg, bar);
            __builtin_amdgcn_fence(__ATOMIC_ACQUIRE, "agent");
            xb_add(&bar[XB_XGEN(b.x)], 1u);
            asm volatile("s_waitcnt vmcnt(0)" ::: "memory");
        } else {
            XB_SPIN(xb_ld(&bar[XB_XGEN(b.x)]) == gen, bar);
            __builtin_amdgcn_fence(__ATOMIC_ACQUIRE, "agent");
            asm volatile("s_waitcnt vmcnt(0)" ::: "memory");
        }
    }
    __syncthreads();
}

struct Args { const float* in[23]; float* out; unsigned char* ws; };
enum { I_XP = 0, I_XS, I_CK, I_CV, I_SCONV, I_SPOOL, I_SFFN, I_GMIX, I_WIN, I_SINK, I_CONVW, I_LNG, I_LNB, I_GW, I_GB, I_PW, I_PSC, I_WOUT, I_GFFN, I_WUP, I_FCW, I_WDN, I_GFIN };

#define CAS __attribute__((address_space(4)))
__device__ __forceinline__ const CAS char* karg_base() { const CAS char* kp = (const CAS char*)__builtin_amdgcn_kernarg_segment_ptr(); asm volatile("" : "+s"(kp)); return kp; }
#define AIN(i) (*(const float* const CAS*)(karg_base() + 8 * (i)))
#define AOUT() (*(float* const CAS*)(karg_base() + 184))
#define AWS() (*(unsigned char* const CAS*)(karg_base() + 192))
template <bool UPPERM> __device__ __forceinline__ void p0_transpose_item(const float* W, int K, int N, const float* g, bf16* WT, LAS float* scr, int item, int lane) {
    const int nblk = N / 32, kb = item / nblk, nb = item % nblk, k0 = 64 * kb, n0 = 32 * nb;
    const int d0 = UPPERM ? (n0 < DFF ? 256 * (n0 >> 7) + (n0 & 127) : 256 * ((n0 - DFF) >> 7) + 128 + ((n0 - DFF) & 127)) : n0;
    f32x4 ld[8]; float scv[8];
#pragma unroll
    for (int i = 0; i < 8; ++i) { const int kk = 8 * i + (lane >> 3); ld[i] = *(const f32x4*)(W + (size_t)(k0 + kk) * N + n0 + 4 * (lane & 7)); scv[i] = g ? g[k0 + kk] : 1.f; }
#pragma unroll
    for (int i = 0; i < 8; ++i) { const int kk = 8 * i + (lane >> 3); LAS float* d = scr + kk * 33 + 4 * (lane & 7);
        d[0] = ld[i][0] * scv[i]; d[1] = ld[i][1] * scv[i]; d[2] = ld[i][2] * scv[i]; d[3] = ld[i][3] * scv[i]; }
    LDS_WAIT(); asm volatile("" ::: "memory");
    const int c = lane & 7;
#pragma unroll
    for (int j = 0; j < 4; ++j) { const int n = (lane >> 3) + 8 * j; const LAS float* s = scr + (8 * c) * 33 + n;
        v4u o; o.x = pk2(s[0 * 33], s[1 * 33]); o.y = pk2(s[2 * 33], s[3 * 33]); o.z = pk2(s[4 * 33], s[5 * 33]); o.w = pk2(s[6 * 33], s[7 * 33]);
        *(GAS v4u*)(WT + (size_t)(d0 + n) * K + k0 + 8 * c) = o; }
    LDS_WAIT(); asm volatile("" ::: "memory");
}
__device__ __forceinline__ void sincos_d(double x, double& s, double& c) {
    const double n = __builtin_rint(x * 0.15915494309189535);
    double r = __builtin_fma(-n, 6.283185307179586, x); r = __builtin_fma(-n, 2.4492935982947064e-16, r);
    const double r2 = r * r; double ts = r, tc = 1.0; s = r; c = 1.0;
#pragma unroll
    for (int k = 1; k <= 14; ++k) { tc = -tc * r2 / (double)((2 * k - 1) * (2 * k)); c += tc; ts = -ts * r2 / (double)((2 * k) * (2 * k + 1)); s += ts; }
}

typedef float f32x16 __attribute__((ext_vector_type(16)));
typedef short bf16x8v __attribute__((ext_vector_type(8), may_alias));
typedef short s16x4 __attribute__((ext_vector_type(4), may_alias));
struct Seg { int smp, b, cu, nrows, row0, pos0; };
__device__ __forceinline__ Seg seg_prompt(int u) { Seg s; s.smp = 0; s.b = u >> 4; s.cu = u & 15; s.nrows = 128; s.row0 = s.b * SEQ + s.cu * 128; s.pos0 = s.cu * 128; return s; }
__device__ __forceinline__ Seg seg_sample(int b) { Seg s; s.smp = 1; s.b = b; s.cu = 0; s.nrows = ST; s.row0 = MP + b * ST; s.pos0 = SEQ; return s; }
struct MixCtx { const bf16* z; bf16* mix; float* out; int l; const float* rope; const bf16* gwb; const bf16* wpT; };
__device__ __forceinline__ int offK(int key, int ch) { return key * 128 + ((ch ^ ((key >> 1) & 7)) << 4); }
__device__ __forceinline__ int offV(int key, int ch) { return key * 128 + ((ch ^ (((key >> 1) & 1) << 2)) << 4); }
__device__ __forceinline__ s16x4 lds_tr(const LAS unsigned char* p) { return __builtin_bit_cast(s16x4, __builtin_amdgcn_ds_read_tr16_b64_v4i16((LAS s16x4*)p)); }
__device__ __forceinline__ unsigned cvtpk(float lo, float hi) { unsigned r; asm volatile("v_cvt_pk_bf16_f32 %0, %1, %2" : "=v"(r) : "v"(lo), "v"(hi)); return r; }
__device__ __forceinline__ v4u pack8(const f32x4 a, const f32x4 c) { v4u w; w.x = cvtpk(a[0], a[1]); w.y = cvtpk(a[2], a[3]); w.z = cvtpk(c[0], c[1]); w.w = cvtpk(c[2], c[3]); return w; }
__device__ __forceinline__ void st8f(float* o, v4u val) { *(f32x4*)o = (f32x4){bflo(val.x), bfhi(val.x), bflo(val.y), bfhi(val.y)}; *(f32x4*)(o + 4) = (f32x4){bflo(val.z), bfhi(val.z), bflo(val.w), bfhi(val.w)}; }

__device__ __forceinline__ void attn_unit(const MixCtx& C, const Seg& sg, const float* sinkp, const float* ck, const float* cv, LAS unsigned char* L, int wave) {
    const int lane = lane_id(), tid = wave * 64 + lane, l = C.l, b = sg.b, cu = sg.cu;
    const bf16* z = C.z; float* out = C.out;
    if (sg.smp) {
        for (int it = tid; it < ST * 48; it += 512) { const int t = it / 48, pr = it % 48, c1 = (pr >> 3) * 64 + (pr & 7);
            bf16* zr = (bf16*)z + (size_t)(sg.row0 + t) * NPROJ; const float x1 = bf2f(zr[c1]), x2 = bf2f(zr[c1 + 8]);
            const float cs = C.rope[(size_t)((SEQ + t) * 8 + (pr & 7)) * 2], sn = C.rope[(size_t)((SEQ + t) * 8 + (pr & 7)) * 2 + 1];
            zr[c1] = (bf16)f2bf(x1 * cs - x2 * sn); zr[c1 + 8] = (bf16)f2bf(x2 * cs + x1 * sn); }
        asm volatile("s_waitcnt vmcnt(0)" ::: "memory"); __syncthreads();
    }
    const int nk = sg.smp ? (WIN + ST) : 256;
    for (int it = tid; it < nk * 32; it += 512) {
        const int c32 = it & 31, kk = it >> 5, kv = c32 >> 4, hk = (c32 >> 3) & 1, ch = c32 & 7;
        v4u val;
        if (sg.smp && kk < WIN) { const float* src = (kv == 0 ? ck : cv) + (size_t)((b * 2 + l) * WIN + kk) * 128 + hk * 64 + 8 * ch; val = pack8(*(const f32x4*)src, *(const f32x4*)(src + 4)); }
        else { if (!sg.smp && cu == 0 && kk < 128) continue;
            const int row = sg.smp ? sg.row0 + (kk - WIN) : sg.row0 - 128 + kk; val = *(const v4u*)(z + (size_t)row * NPROJ + ZK + c32 * 8); }
        const int off = kv == 0 ? hk * 32768 + offK(kk, ch) : 65536 + hk * 32768 + offV(kk, ch);
        *(LAS v4u*)(L + off) = val;
        if (sg.smp) { if (kk >= WIN) st8f(out + (kv == 0 ? O_SK : O_SV) + (size_t)((b * 2 + l) * ST + (kk - WIN)) * 128 + hk * 64 + ch * 8, val); }
        else if (cu == 15 && kk >= 128) st8f(out + (kv == 0 ? O_PK : O_PV) + (size_t)((b * 2 + l) * WIN + (kk - 128)) * 128 + hk * 64 + ch * 8, val);
    }
    const int hq = sg.smp ? (wave & 3) : ((wave >> 2) * 2 + ((wave >> 1) & 1)), hk = hq >> 1, half = wave & 1, h = lane >> 5, r32 = lane & 31;
    const int ntask = sg.smp ? (wave < 4 ? 1 : 0) : 2;
    bf16x8v qfa[2][4];
#pragma unroll
    for (int qc = 0; qc < 2; ++qc) if (qc < ntask) { const int qrow = sg.smp ? sg.row0 + r32 : sg.row0 + qc * 64 + half * 32 + r32;
#pragma unroll
        for (int s = 0; s < 4; ++s) qfa[qc][s] = *(const bf16x8v*)(z + (size_t)qrow * NPROJ + ZQ + hq * 64 + 16 * s + 8 * h); }
    __syncthreads();
    const float sk = sinkp[l * 4 + hq];
    const LAS unsigned char* Kimg = L + hk * 32768; const LAS unsigned char* Vimg = L + 65536 + hk * 32768;
    constexpr float C1 = 0.125f * 1.4426950408889634f, LOG2E = 1.4426950408889634f;
#pragma unroll
    for (int qc = 0; qc < 2; ++qc) { if (qc < ntask) {
        const int qrow = sg.smp ? sg.row0 + r32 : sg.row0 + qc * 64 + half * 32 + r32, keybase = sg.smp ? 0 : qc * 64;
        const int Tstart = (!sg.smp && cu == 0) ? (qc == 0 ? 4 : 2) : 0, Tend = sg.smp ? 5 : 6;
        bf16x8v qf[4];
#pragma unroll
        for (int s = 0; s < 4; ++s) qf[s] = qfa[qc][s];
        f32x16 S[6]; float mx = -3.0e38f;
#pragma unroll
        for (int T = 0; T < 6; ++T) {
            if (T >= Tstart && T < Tend) {
                f32x16 a = {0.f, 0.f, 0.f, 0.f, 0.f, 0.f, 0.f, 0.f, 0.f, 0.f, 0.f, 0.f, 0.f, 0.f, 0.f, 0.f};
                const int key = keybase + 32 * T + r32;
#pragma unroll
                for (int s = 0; s < 4; ++s) { const bf16x8v kf = *(const LAS bf16x8v*)(Kimg + offK(key, 2 * s + h)); a = __builtin_amdgcn_mfma_f32_32x32x16_bf16(kf, qf[s], a, 0, 0, 0); }
                S[T] = a;
#pragma unroll
                for (int r = 0; r < 16; ++r) mx = fmaxf(mx, a[r]);
            } else {
#pragma unroll
                for (int r = 0; r < 16; ++r) S[T][r] = -3.0e38f;
            }
        }
        mx = fmaxf(mx, __shfl_xor(mx, 32));
        const float m = fmaxf(mx * 0.125f, sk), mb = m * LOG2E;
        float sum = 0.f;
#pragma unroll
        for (int T = 0; T < 6; ++T)
#pragma unroll
            for (int r = 0; r < 16; ++r) { const float p = __builtin_amdgcn_exp2f(S[T][r] * C1 - mb); S[T][r] = p; sum += p; }
        sum += __shfl_xor(sum, 32);
        const float inv = __builtin_amdgcn_rcpf(sum + __builtin_amdgcn_exp2f((sk - m) * LOG2E));
        f32x16 O[2];
#pragma unroll
        for (int dt = 0; dt < 2; ++dt)
#pragma unroll
            for (int r = 0; r < 16; ++r) O[dt][r] = 0.f;
        const int q4 = (lane & 15) >> 2, p4 = lane & 3, g2 = (lane >> 4) & 1;
#pragma unroll
        for (int T = 0; T < 6; ++T) {
            if (T >= Tstart && T < Tend) {
#pragma unroll
                for (int s = 0; s < 2; ++s) {
                    v4u pw; pw.x = cvtpk(S[T][8 * s + 0], S[T][8 * s + 1]); pw.y = cvtpk(S[T][8 * s + 2], S[T][8 * s + 3]); pw.z = cvtpk(S[T][8 * s + 4], S[T][8 * s + 5]); pw.w = cvtpk(S[T][8 * s + 6], S[T][8 * s + 7]);
                    const bf16x8v pf = __builtin_bit_cast(bf16x8v, pw);
                    const int k0 = keybase + 32 * T + 16 * s + 4 * h + q4;
#pragma unroll
                    for (int dt = 0; dt < 2; ++dt) {
                        const int chn = 2 * g2 + (p4 >> 1) + 4 * dt;
                        const s16x4 lo = lds_tr(Vimg + offV(k0, chn) + 8 * (p4 & 1)), hi = lds_tr(Vimg + offV(k0 + 8, chn) + 8 * (p4 & 1));
                        const bf16x8v vf = (bf16x8v){lo[0], lo[1], lo[2], lo[3], hi[0], hi[1], hi[2], hi[3]};
                        O[dt] = __builtin_amdgcn_mfma_f32_32x32x16_bf16(vf, pf, O[dt], 0, 0, 0);
                    }
                }
            }
        }
        bf16* op = C.mix + (size_t)qrow * DM + hq * 64 + 4 * h;
#pragma unroll
        for (int dt = 0; dt < 2; ++dt)
#pragma unroll
            for (int rg = 0; rg < 4; ++rg) { v2u w; w.x = cvtpk(O[dt][4 * rg] * inv, O[dt][4 * rg + 1] * inv); w.y = cvtpk(O[dt][4 * rg + 2] * inv, O[dt][4 * rg + 3] * inv);
                *(v2u*)(op + 32 * dt + 8 * rg) = w; }
    } }
    __syncthreads();
}
__device__ __forceinline__ int offGv(int j, int byte) { return 512 * j + ((((byte >> 6) ^ (j & 3))) << 6) + (byte & 63); }
__device__ __forceinline__ void gmlp_unit(const MixCtx& C, const Seg& sg, const float* lng, const float* lnb, const float* gb, LAS unsigned char* L, int wave) {
    const int lane = lane_id(), l = C.l, r0 = sg.row0, nrows = sg.nrows;
    const bf16* z = C.z;
    {
        const f32x4 gg = *(const f32x4*)(lng + l * 256 + 4 * lane), bb = *(const f32x4*)(lnb + l * 256 + 4 * lane);
        v2u raws[16];
#pragma unroll
        for (int jj = 0; jj < 16; ++jj) { const int j = wave + 8 * jj; if (j < nrows) raws[jj] = *(const v2u*)(z + (size_t)(r0 + j) * NPROJ + ZGV + 4 * lane); else raws[jj] = (v2u){0u, 0u}; }
        float xv[16][4], s1[16], s2[16];
#pragma unroll
        for (int jj = 0; jj < 16; ++jj) { const v2u raw = raws[jj];
            xv[jj][0] = gelu_t(bflo(raw.x)); xv[jj][1] = gelu_t(bfhi(raw.x)); xv[jj][2] = gelu_t(bflo(raw.y)); xv[jj][3] = gelu_t(bfhi(raw.y));
            s1[jj] = (xv[jj][0] + xv[jj][1]) + (xv[jj][2] + xv[jj][3]);
            s2[jj] = (xv[jj][0] * xv[jj][0] + xv[jj][1] * xv[jj][1]) + (xv[jj][2] * xv[jj][2] + xv[jj][3] * xv[jj][3]); }
#pragma unroll
        for (int o = 1; o < 64; o <<= 1) {
#pragma unroll
            for (int jj = 0; jj < 16; ++jj) { s1[jj] += __shfl_xor(s1[jj], o); s2[jj] += __shfl_xor(s2[jj], o); } }
#pragma unroll
        for (int jj = 0; jj < 16; ++jj) { const int j = wave + 8 * jj; if (j < nrows) {
            const float mean = s1[jj] * (1.f / 256.f), var = s2[jj] * (1.f / 256.f) - mean * mean;
            const float rstd = __builtin_amdgcn_rsqf(var + EPS);
            const f32x4 y = (f32x4){(xv[jj][0] - mean) * rstd * gg[0] + bb[0], (xv[jj][1] - mean) * rstd * gg[1] + bb[1], (xv[jj][2] - mean) * rstd * gg[2] + bb[2], (xv[jj][3] - mean) * rstd * gg[3] + bb[3]};
            v2u w; w.x = cvtpk(y[0], y[1]); w.y = cvtpk(y[2], y[3]);
            *(LAS v2u*)(L + offGv(j, 8 * lane)) = w;
            if (sg.smp) *(f32x4*)(C.out + O_SG + (size_t)((sg.b * 2 + l) * ST + j) * 256 + 4 * lane) = y;
        } }
    }
    __syncthreads();
    const int g = wave >> 1, dt = wave & 1, h = lane >> 5, r32 = lane & 31, q4 = (lane & 15) >> 2, p4 = lane & 3, g2 = (lane >> 4) & 1;
    const int nks = nrows >> 4, nit = nrows >> 5;
    f32x16 acc[4];
#pragma unroll
    for (int it = 0; it < 4; ++it)
#pragma unroll
        for (int r = 0; r < 16; ++r) acc[it][r] = 0.f;
    const bf16* wg = C.gwb + (size_t)((l * 4 + g) * 128) * 128;
    const int cb = 2 * (64 * g + 32 * dt + 16 * g2 + 4 * p4);
#pragma unroll
    for (int ks = 0; ks < 8; ++ks) {
        if (ks < nks) {
            const int j0 = 16 * ks + 8 * h;
            const s16x4 lo = lds_tr(L + offGv(j0 + q4, cb)), hi = lds_tr(L + offGv(j0 + 4 + q4, cb));
            const bf16x8v af = (bf16x8v){lo[0], lo[1], lo[2], lo[3], hi[0], hi[1], hi[2], hi[3]};
#pragma unroll
            for (int it = 0; it < 4; ++it) { if ((it < 2 && ks >= 4) || it >= nit) continue;
                const bf16x8v bf = *(const bf16x8v*)(wg + (size_t)(32 * it + r32) * 128 + 16 * ks + 8 * h);
                acc[it] = __builtin_amdgcn_mfma_f32_32x32x16_bf16(af, bf, acc[it], 0, 0, 0); }
        }
    }
    v2u uraw[4][4]; float bsv[4];
#pragma unroll
    for (int it = 0; it < 4; ++it) if (it < nit) { const int i = 32 * it + r32; bsv[it] = gb[(l * 4 + g) * 128 + i];
        const bf16* up = z + (size_t)(r0 + i) * NPROJ + ZGU + 64 * g + 32 * dt + 4 * h;
#pragma unroll
        for (int rg = 0; rg < 4; ++rg) uraw[it][rg] = *(const v2u*)(up + 8 * rg); }
#pragma unroll
    for (int it = 0; it < 4; ++it) {
        if (it < nit) {
            const int i = 32 * it + r32; const float bs = bsv[it];
            bf16* op = C.mix + (size_t)(r0 + i) * DM + 512 + 64 * g + 32 * dt + 4 * h;
#pragma unroll
            for (int rg = 0; rg < 4; ++rg) { const v2u ur = uraw[it][rg];
                v2u w; w.x = cvtpk(gelu_t(bflo(ur.x)) * (acc[it][4 * rg] + bs), gelu_t(bfhi(ur.x)) * (acc[it][4 * rg + 1] + bs)); w.y = cvtpk(gelu_t(bflo(ur.y)) * (acc[it][4 * rg + 2] + bs), gelu_t(bfhi(ur.y)) * (acc[it][4 * rg + 3] + bs));
                *(v2u*)(op + 8 * rg) = w; }
        }
    }
    __syncthreads();
}
__device__ __forceinline__ int offPl(int t, int ch) { return 512 * t + ((((ch >> 3) ^ (t & 15))) << 4) + 2 * (ch & 7); }
__device__ __forceinline__ void pool_unit(const MixCtx& C, const Seg& sg, const float* spool, const float* psc, LAS unsigned char* L, int wave) {
    const int lane = lane_id(), tid = wave * 64 + lane, l = C.l, r0 = sg.row0, nrows = sg.nrows;
    const bf16* z = C.z;
    LAS unsigned char* Pim = L; LAS unsigned char* Qim = L + 73728;
    const bool st_out = sg.smp || sg.cu == 15;
    for (int it = tid; it < (nrows + 15) * 32; it += 512) {
        const int e = it >> 5, c = it & 31; v4u val = (v4u){0u, 0u, 0u, 0u};
        if (e >= 15 || (!sg.smp && sg.cu > 0)) val = *(const v4u*)(z + (size_t)(r0 - 15 + e) * NPROJ + ZPI + 8 * c);
        else if (sg.smp) { const float* src = spool + (size_t)((sg.b * 2 + l) * 15 + e) * 256 + 8 * c; val = pack8(*(const f32x4*)src, *(const f32x4*)(src + 4)); }
        *(LAS v4u*)(Pim + e * 512 + c * 16) = val;
        if (st_out && e >= nrows) st8f(C.out + (sg.smp ? O_SP : O_PP) + (size_t)((sg.b * 2 + l) * 15 + (e - nrows)) * 256 + 8 * c, val);
    }
    __syncthreads();
    {
        const int ch = tid & 255, t0 = (tid >> 8) * 64, gq = ch >> 6, win = 2 << gq;
        if (t0 < nrows) {
            const int tend = (t0 + 64) < nrows ? (t0 + 64) : nrows;
            const LAS bf16* P = (const LAS bf16*)Pim;
            float sum = 0.f;
            for (int j = 1; j < win; ++j) sum += bf2f(P[(15 + t0 - j) * 256 + ch]);
            for (int t = t0; t < tend; t += 8) {
                float xs[8], xo[8];
#pragma unroll
                for (int i = 0; i < 8; ++i) { xs[i] = bf2f(P[(15 + t + i) * 256 + ch]); xo[i] = bf2f(P[(15 + t + i - (win - 1)) * 256 + ch]); }
#pragma unroll
                for (int i = 0; i < 8; ++i) { sum += xs[i];
                    const int pos = sg.pos0 + t + i; const int cnt = (pos + 1) < win ? (pos + 1) : win;
                    *(LAS bf16*)(Qim + offPl(t + i, ch)) = (bf16)f2bf(sum * __builtin_amdgcn_rcpf((float)cnt) - xs[i]);
                    sum -= xo[i]; }
            }
        }
    }
    __syncthreads();
    const int g = wave >> 1, dt = wave & 1, h = lane >> 5, r32 = lane & 31;
    bf16x8v af[4];
#pragma unroll
    for (int ks = 0; ks < 4; ++ks) af[ks] = *(const bf16x8v*)(C.wpT + (size_t)((l * 4 + g) * 64 + 32 * dt + r32) * 64 + 16 * ks + 8 * h);
    for (int tt = 0; tt < (nrows >> 5); ++tt) {
        f32x16 a = {0.f, 0.f, 0.f, 0.f, 0.f, 0.f, 0.f, 0.f, 0.f, 0.f, 0.f, 0.f, 0.f, 0.f, 0.f, 0.f};
        const int t = 32 * tt + r32;
#pragma unroll
        for (int ks = 0; ks < 4; ++ks) { const bf16x8v bf = *(const LAS bf16x8v*)(Qim + 512 * t + (((8 * g + 2 * ks + h) ^ (t & 15)) << 4)); a = __builtin_amdgcn_mfma_f32_32x32x16_bf16(af[ks], bf, a, 0, 0, 0); }
        bf16* op = C.mix + (size_t)(r0 + t) * DM + 768 + 64 * g + 32 * dt + 4 * h; const float* sc = psc + l * 256 + 64 * g + 32 * dt + 4 * h;
#pragma unroll
        for (int rg = 0; rg < 4; ++rg) { const f32x4 s4 = *(const f32x4*)(sc + 8 * rg);
            v2u w; w.x = cvtpk(a[4 * rg] * s4[0], a[4 * rg + 1] * s4[1]); w.y = cvtpk(a[4 * rg + 2] * s4[2], a[4 * rg + 3] * s4[3]); *(v2u*)(op + 8 * rg) = w; }
    }
    __syncthreads();
}
__device__ __forceinline__ void conv_unit(const MixCtx& C, const Seg& sg, const float* convw, const float* sconv, int wave) {
    const int lane = lane_id(), tid = wave * 64 + lane, l = C.l;
    const int r0 = sg.row0, cg = tid & 31, t0 = (tid >> 5) * 8, ch = 8 * cg;
    if (t0 >= sg.nrows) return;
    const bf16* z = C.z;
    float w[3][8];
#pragma unroll
    for (int j = 0; j < 3; ++j) { const f32x4 a = *(const f32x4*)(convw + (l * 3 + j) * 256 + ch), c = *(const f32x4*)(convw + (l * 3 + j) * 256 + ch + 4);
        w[j][0] = a[0]; w[j][1] = a[1]; w[j][2] = a[2]; w[j][3] = a[3]; w[j][4] = c[0]; w[j][5] = c[1]; w[j][6] = c[2]; w[j][7] = c[3]; }
    float m1[8], m2[8];
#pragma unroll
    for (int e = 0; e < 8; ++e) { m1[e] = 0.f; m2[e] = 0.f; }
    const bool st_out = sg.smp || sg.cu == 15;
#pragma unroll
    for (int i = -2; i < 8; ++i) {
        const int t = t0 + i; float m0[8];
        if (t >= 0 || (!sg.smp && sg.cu > 0)) { const bf16* zr = z + (size_t)(r0 + t) * NPROJ; const v4u a = *(const v4u*)(zr + ZCC + ch), c = *(const v4u*)(zr + ZCH + ch);
            m0[0] = bflo(a.x) * bflo(c.x); m0[1] = bfhi(a.x) * bfhi(c.x); m0[2] = bflo(a.y) * bflo(c.y); m0[3] = bfhi(a.y) * bfhi(c.y); m0[4] = bflo(a.z) * bflo(c.z); m0[5] = bfhi(a.z) * bfhi(c.z); m0[6] = bflo(a.w) * bflo(c.w); m0[7] = bfhi(a.w) * bfhi(c.w); }
        else if (sg.smp) { const float* sp = sconv + (size_t)((sg.b * 2 + l) * 2 + (t + 2)) * 256 + ch; const f32x4 a = *(const f32x4*)sp, c = *(const f32x4*)(sp + 4);
            m0[0] = a[0]; m0[1] = a[1]; m0[2] = a[2]; m0[3] = a[3]; m0[4] = c[0]; m0[5] = c[1]; m0[6] = c[2]; m0[7] = c[3]; }
        else {
#pragma unroll
            for (int e = 0; e < 8; ++e) m0[e] = 0.f; }
        if (i >= 0) {
            const v4u cbv = *(const v4u*)(z + (size_t)(r0 + t) * NPROJ + ZCB + ch);
            const float cbf[8] = {bflo(cbv.x), bfhi(cbv.x), bflo(cbv.y), bfhi(cbv.y), bflo(cbv.z), bfhi(cbv.z), bflo(cbv.w), bfhi(cbv.w)};
            float o[8];
#pragma unroll
            for (int e = 0; e < 8; ++e) o[e] = cbf[e] * (w[0][e] * m2[e] + w[1][e] * m1[e] + w[2][e] * m0[e]);
            v4u wv; wv.x = cvtpk(o[0], o[1]); wv.y = cvtpk(o[2], o[3]); wv.z = cvtpk(o[4], o[5]); wv.w = cvtpk(o[6], o[7]);
            *(v4u*)(C.mix + (size_t)(r0 + t) * DM + 256 + ch) = wv;
            if (st_out && t >= sg.nrows - 2) { float* o2 = C.out + (sg.smp ? O_SC : O_PC) + (size_t)((sg.b * 2 + l) * 2 + (t - (sg.nrows - 2))) * 256 + ch;
                *(f32x4*)o2 = (f32x4){m0[0], m0[1], m0[2], m0[3]}; *(f32x4*)(o2 + 4) = (f32x4){m0[4], m0[5], m0[6], m0[7]}; }
        }
#pragma unroll
        for (int e = 0; e < 8; ++e) { m2[e] = m1[e]; m1[e] = m0[e]; }
    }
}

template <int NT, int NCH>
__device__ __forceinline__ void sg_accumulate(const bf16* A, int lda, const bf16* Bt, int K, int t0, int n0, int kc0, LAS unsigned char* Lw, int lane, f32x16 (&acc)[NT]) {
    constexpr int NR = NT * 32 + 32, NI = NR / 8;
    const int lr = lane >> 3, lc = lane & 7, h = lane >> 5, r32 = lane & 31;
#pragma unroll
    for (int t = 0; t < NT; ++t)
#pragma unroll
        for (int r = 0; r < 16; ++r) acc[t][r] = 0.f;
    const bf16* rowp[NI];
#pragma unroll
    for (int i = 0; i < NI; ++i) { const int r = 8 * i + lr; rowp[i] = (i < 4 ? Bt + (size_t)(n0 + r) * K : A + (size_t)(t0 + r - 32) * lda) + kc0 * 64 + 8 * lc; }
    v4u buf[2][NI];
#pragma unroll
    for (int i = 0; i < NI; ++i) buf[0][i] = *(const v4u*)rowp[i];
#pragma unroll
    for (int c = 0; c < NCH; ++c) {
        if (c + 1 < NCH) {
#pragma unroll
            for (int i = 0; i < NI; ++i) buf[(c + 1) & 1][i] = *(const v4u*)(rowp[i] + 64 * (c + 1)); }
#pragma unroll
        for (int i = 0; i < NI; ++i) *(LAS v4u*)(Lw + (8 * i + lr) * 144 + lc * 16) = buf[c & 1][i];
#pragma unroll
        for (int s4 = 0; s4 < 4; ++s4) { const bf16x8v bw = *(const LAS bf16x8v*)(Lw + r32 * 144 + 32 * s4 + 16 * h);
#pragma unroll
            for (int t = 0; t < NT; ++t) { const bf16x8v ba = *(const LAS bf16x8v*)(Lw + (32 + 32 * t + r32) * 144 + 32 * s4 + 16 * h); acc[t] = __builtin_amdgcn_mfma_f32_32x32x16_bf16(bw, ba, acc[t], 0, 0, 0); } }
    }
}
template <int NT, int NSUM>
__device__ __forceinline__ f32x4 sg_reduce(const f32x16 (&a)[NT], int wave, LAS unsigned char* L, int lane, int rt, int rg, int src0, bool valid) {
    __syncthreads();
#pragma unroll
    for (int t = 0; t < NT; ++t)
#pragma unroll
        for (int g4 = 0; g4 < 4; ++g4) *(LAS f32x4*)(L + (size_t)((((wave * NT + t) * 4 + g4) * 64 + lane) * 16)) = (f32x4){a[t][4 * g4], a[t][4 * g4 + 1], a[t][4 * g4 + 2], a[t][4 * g4 + 3]};
    __syncthreads();
    f32x4 s = (f32x4){0.f, 0.f, 0.f, 0.f};
    if (valid) {
#pragma unroll
        for (int w = 0; w < NSUM; ++w) s += *(const LAS f32x4*)(L + (size_t)(((((src0 + w) * NT + rt) * 4 + rg) * 64 + lane) * 16)); }
    return s;
}
constexpr int SG_STG = 14336;
constexpr int SG_AUX = 8 * SG_STG;

template <int NTT>
__device__ __forceinline__ void sres_epilogue(bool valid, f32x4 v, int t0, int n0, int cb, int rt, int rg, int lane, int tid, bf16* xbs, float* ssq_out, LAS float* red) {
    const int h = lane >> 5, r32 = lane & 31;
    if (valid) { const int token = t0 + 32 * rt + r32, chn = n0 + 8 * rg + 4 * h;
        const v2u r = *(const v2u*)(xbs + (size_t)token * DM + chn);
        v2u w; w.x = cvtpk(bflo(r.x) + v[0], bfhi(r.x) + v[1]); w.y = cvtpk(bflo(r.y) + v[2], bfhi(r.y) + v[3]); *(v2u*)(xbs + (size_t)token * DM + chn) = w;
        const float q0 = bflo(w.x), q1 = bfhi(w.x), q2 = bflo(w.y), q3 = bfhi(w.y);
        float sq = (q0 * q0 + q1 * q1) + (q2 * q2 + q3 * q3); sq += __shfl_xor(sq, 32);
        if (h == 0) red[(rt * 4 + rg) * 32 + r32] = sq; }
    __syncthreads();
    if (tid < 32 * NTT) { const int rt2 = tid >> 5, r = tid & 31; ssq_out[cb * 256 + t0 + tid] = (red[(rt2 * 4 + 0) * 32 + r] + red[(rt2 * 4 + 1) * 32 + r]) + (red[(rt2 * 4 + 2) * 32 + r] + red[(rt2 * 4 + 3) * 32 + r]); }
    __syncthreads();
}

__global__ void __launch_bounds__(512, 2) trunk_fwd(Args args) {
    extern __shared__ __attribute__((aligned(16))) unsigned char lds[];
    LAS unsigned char* L = (LAS unsigned char*)lds;
    volatile LAS unsigned* MISC = (volatile LAS unsigned*)(L + MISC_OFF);
    unsigned* ctl = (unsigned*)(AWS() + WS_CTL);
    const int wave = __builtin_amdgcn_readfirstlane(threadIdx.x >> 6);
    if (threadIdx.x < 32) MISC[threadIdx.x] = 0u;
    __syncthreads();
    XcdBarrier bar = xcd_barrier_post(ctl + CW_BAR, MISC + 8);
#define DERIVE() int bx = blockIdx.x, G = gridDim.x; asm volatile("" : "+s"(bx), "+s"(G)); const int lane = lane_id(), tid = wave * 64 + lane, gw = bx * 8 + wave, NGW = G * 8; (void)lane; (void)gw; (void)NGW; unsigned char* ws = AWS(); float* out = AOUT(); \
    float* rope = (float*)(ws + WS_ROPE); bf16* gwb = (bf16*)(ws + WS_ROPE + 262144); bf16* wpT = (bf16*)(ws + WS_ROPE + 524288); float* ssqSA = (float*)(ws + WS_ROPE + 655360); float* ssqSB = (float*)(ws + WS_ROPE + 720896); (void)gwb; (void)wpT; (void)ssqSA; (void)ssqSB; bf16* Win_t = (bf16*)(ws + WS_WIN); bf16* Wout_t = (bf16*)(ws + WS_WOUT); bf16* Wup_t = (bf16*)(ws + WS_WUP); bf16* Wdn_t = (bf16*)(ws + WS_WDN); \
    float* ssqA = (float*)(ws + WS_SSQA); float* ssqB = (float*)(ws + WS_SSQB); float* headf = (float*)(ws + WS_HEAD); float* tailf = (float*)(ws + WS_TAIL); bf16* xb = (bf16*)(ws + WS_XB); bf16* zb = (bf16*)(ws + WS_Z); \
    bf16* mixb = (bf16*)(ws + WS_MIX); bf16* actb = (bf16*)(ws + WS_ACT); bf16* upsb = (bf16*)(ws + WS_UPS); LAS float* aux = (LAS float*)(L + AUX_OFF); \
    (void)rope; (void)Win_t; (void)Wout_t; (void)Wup_t; (void)Wdn_t; (void)ssqA; (void)ssqB; (void)headf; (void)tailf; (void)xb; (void)zb; (void)mixb; (void)actb; (void)upsb; (void)aux; (void)out;
#define IN(k) true
#define SEAM(k) xcd_barrier(bar, wave)

    if (IN(0)) { DERIVE()
        LAS float* scr = (LAS float*)(L + wave * 16384);
        constexpr int I_IN = (DM / 64) * (NPROJ / 32), I_OUT = (DM / 64) * (DM / 32), I_UP = (DM / 64) * (NUP / 32), I_DN = (DFF / 64) * (DM / 32), I_L = I_IN + I_OUT + I_UP + I_DN;
        for (int it = gw; it < 2 * I_L; it += NGW) {
            const int l = it / I_L; int r = it % I_L;
            if (r < I_IN) { p0_transpose_item<false>(AIN(I_WIN) + (size_t)l * DM * NPROJ, DM, NPROJ, AIN(I_GMIX) + l * DM, Win_t + (size_t)l * NPROJ * DM, scr, r, lane); continue; } r -= I_IN;
            if (r < I_OUT) { p0_transpose_item<false>(AIN(I_WOUT) + (size_t)l * DM * DM, DM, DM, nullptr, Wout_t + (size_t)l * DM * DM, scr, r, lane); continue; } r -= I_OUT;
            if (r < I_UP) { p0_transpose_item<true>(AIN(I_WUP) + (size_t)l * DM * NUP, DM, NUP, AIN(I_GFFN) + l * DM, Wup_t + (size_t)l * NUP * DM, scr, r, lane); continue; } r -= I_UP;
            p0_transpose_item<false>(AIN(I_WDN) + (size_t)l * DFF * DM, DFF, DM, nullptr, Wdn_t + (size_t)l * DM * DFF, scr, r, lane);
        }
        for (int m0 = gw; m0 < MT; m0 += 4 * NGW) {
            f32x4 v[4][4];
#pragma unroll
            for (int r = 0; r < 4; ++r) { const int m = m0 + r * NGW; if (m < MT) { const float* xr = m < MP ? AIN(I_XP) + (size_t)m * DM : AIN(I_XS) + (size_t)(m - MP) * DM; const GAS f32x4* x4 = (const GAS f32x4*)xr + lane;
#pragma unroll
                for (int j = 0; j < 4; ++j) v[r][j] = x4[64 * j]; } }
#pragma unroll
            for (int r = 0; r < 4; ++r) { const int m = m0 + r * NGW; if (m < MT) { float s = 0.f;
                GAS unsigned long long* o8 = (GAS unsigned long long*)(xb + (size_t)m * DM) + lane;
#pragma unroll
                for (int j = 0; j < 4; ++j) { const unsigned w0 = pk2(v[r][j].x, v[r][j].y), w1 = pk2(v[r][j].z, v[r][j].w); o8[64 * j] = (unsigned long long)w0 | ((unsigned long long)w1 << 32);
                    s += (bflo(w0) * bflo(w0) + bfhi(w0) * bfhi(w0)) + (bflo(w1) * bflo(w1) + bfhi(w1) * bfhi(w1)); }
                s = wave_sum(s);
                if (m < MP) { if (lane < 4) ssqA[(size_t)lane * MT + m] = lane == 0 ? s : 0.f; } else if (lane == 0) ssqSA[m - MP] = s; } }
        }
        for (int i = bx * 512 + tid; i < (SEQ + ST) * 8; i += G * 512) {
            const int pos = i >> 3, f = i & 7;
            const double invf[8] = {1.0, 0.19392274474868576, 0.03760603093086393, 0.007292664737217109, 0.001414213562373095, 0.0002742481756762073, 5.318295896944988e-05, 1.031338537721246e-05};
            double fr = 1.0;
#pragma unroll
            for (int j = 0; j < 8; ++j) fr = (f == j) ? invf[j] : fr;
            const float ang = (float)pos * (float)fr; double s, c; sincos_d((double)ang, s, c);
            rope[2 * i] = (float)c; rope[2 * i + 1] = (float)s;
        }
        for (int i = bx * 512 + tid; i < 2 * 4 * 128 * 128; i += G * 512) { const int j = i & 127, ii = (i >> 7) & 127; gwb[i] = (bf16)((j >> 6) <= (ii >> 6) ? f2bf(AIN(I_GW)[i]) : 0u); }
        for (int i = bx * 512 + tid; i < 2 * 4 * 64 * 64; i += G * 512) { const int c = i & 63, d = (i >> 6) & 63, lg = i >> 12; wpT[i] = (bf16)f2bf(AIN(I_PW)[(size_t)(lg * 64 + c) * 64 + d]); }
        SEAM(0);
    }

    for (int l = 0; l < 2; ++l) {
        const int pb = 1 + 6 * l;
        if (IN(pb)) { DERIVE()
            pg8::Gemm g{xb, Win_t + (size_t)l * NPROJ * DM, MP, NPROJ, DM, DM}; pg8::StaticOrder S; S.init(MP, NPROJ, G, bx);
            pg8::EpiRow<1> E{{}, zb, NPROJ, ssqA, l == 0 ? 1 : 4, aux, rope, L + AUX_OFF + 16384};
            pg8::gemm_phase<pg8::EpiRow<1>, true, true>(L, g, S, E, wave);
            {
                LAS float* rsl = (LAS float*)(L + SG_AUX); const int np = l == 0 ? 1 : 32;
                for (int su = bx; su < 256; su += G) { const int t0 = (su & 3) * 64, n0 = (su >> 2) * 32;
                    if (tid < 64) { float sq = 0.f; for (int p = 0; p < np; ++p) sq += ssqSA[p * 256 + t0 + tid]; rsl[tid] = __builtin_amdgcn_rsqf(sq * (1.0f / DM) + EPS); }
                    f32x16 acc2[2]; sg_accumulate<2, 2>(xb + (size_t)MP * DM, DM, Win_t + (size_t)l * NPROJ * DM, DM, t0, n0, 2 * wave, L + wave * SG_STG, lane, acc2);
                    const int rt = wave >> 2, rg = wave & 3;
                    const f32x4 v = sg_reduce<2, 8>(acc2, wave, L, lane, rt, rg, 0, true);
                    const int tl = 32 * rt + (lane & 31); const float rs = rsl[tl];
                    v2u w; w.x = cvtpk(v[0] * rs, v[1] * rs); w.y = cvtpk(v[2] * rs, v[3] * rs);
                    *(v2u*)(zb + (size_t)(MP + t0 + tl) * NPROJ + n0 + 8 * rg + 4 * (lane >> 5)) = w;
                    __syncthreads(); }
            }
            SEAM(pb);
        }
        if (IN(pb + 1)) { DERIVE()
            MixCtx C{zb, mixb, out, l, rope, gwb, wpT};
            for (int u = bx; u < 256 + 4 * SB; u += G) {
                if (u < 256) { const Seg sg = seg_prompt(u);
                    attn_unit(C, sg, AIN(I_SINK), AIN(I_CK), AIN(I_CV), L, wave);
                    gmlp_unit(C, sg, AIN(I_LNG), AIN(I_LNB), AIN(I_GB), L, wave);
                    conv_unit(C, sg, AIN(I_CONVW), AIN(I_SCONV), wave);
                    pool_unit(C, sg, AIN(I_SPOOL), AIN(I_PSC), L, wave);
                } else { const Seg sg = seg_sample((u - 256) >> 2); const int kind = (u - 256) & 3;
                    if (kind == 0) conv_unit(C, sg, AIN(I_CONVW), AIN(I_SCONV), wave);
                    else if (kind == 1) attn_unit(C, sg, AIN(I_SINK), AIN(I_CK), AIN(I_CV), L, wave);
                    else if (kind == 2) gmlp_unit(C, sg, AIN(I_LNG), AIN(I_LNB), AIN(I_GB), L, wave);
                    else pool_unit(C, sg, AIN(I_SPOOL), AIN(I_PSC), L, wave);
                }
            }
            SEAM(pb + 1);
        }
        if (IN(pb + 2)) { DERIVE()
            pg8::Gemm g{mixb, Wout_t + (size_t)l * DM * DM, MP, DM, DM, DM}; pg8::StaticOrder S; S.init(MP, DM, G, bx);
            pg8::EpiRes E{{}, xb, xb, ssqB, aux};
            pg8::gemm_phase<pg8::EpiRes, true, true>(L, g, S, E, wave);
            {
                LAS float* red = (LAS float*)(L + SG_AUX);
                for (int su = bx; su < 256; su += G) { const int t0 = (su & 7) * 32, cb = su >> 3, n0 = cb * 32;
                    f32x16 acc1[1]; sg_accumulate<1, 2>(mixb + (size_t)MP * DM, DM, Wout_t + (size_t)l * DM * DM, DM, t0, n0, 2 * wave, L + wave * SG_STG, lane, acc1);
                    const bool valid = wave < 4; const f32x4 v = sg_reduce<1, 8>(acc1, wave, L, lane, 0, wave & 3, 0, valid);
                    sres_epilogue<1>(valid, v, t0, n0, cb, 0, wave & 3, lane, tid, xb + (size_t)MP * DM, ssqSB, red); }
            }
            SEAM(pb + 2);
        }
        if (IN(pb + 3)) { DERIVE()
            pg8::Gemm g{xb, Wup_t + (size_t)l * NUP * DM, MP, NUP, DM, DM}; pg8::StaticOrder S; S.init(MP, NUP, G, bx);
            pg8::EpiUpAct E{{}, actb, ssqB, 4, aux, (LAS f32x4*)(L + AUX_OFF + 8192), (LAS float*)(L + AUX_OFF + 10240), AIN(I_FCW) + (size_t)l * 3 * NUP, headf, tailf, out + O_PF + (size_t)l * 2 * NUP};
            pg8::gemm_phase<pg8::EpiUpAct, true, true>(L, g, S, E, wave);
            {
                LAS float* rsl = (LAS float*)(L + SG_AUX);
                for (int su = bx; su < 4 * (NUP / 32); su += G) { const int t0 = (su & 3) * 64, n0 = (su >> 2) * 32;
                    if (tid < 64) { float sq = 0.f; for (int p = 0; p < 32; ++p) sq += ssqSB[p * 256 + t0 + tid]; rsl[tid] = __builtin_amdgcn_rsqf(sq * (1.0f / DM) + EPS); }
                    f32x16 acc2[2]; sg_accumulate<2, 2>(xb + (size_t)MP * DM, DM, Wup_t + (size_t)l * NUP * DM, DM, t0, n0, 2 * wave, L + wave * SG_STG, lane, acc2);
                    const int rt = wave >> 2, rg = wave & 3;
                    const f32x4 v = sg_reduce<2, 8>(acc2, wave, L, lane, rt, rg, 0, true);
                    const int tl = 32 * rt + (lane & 31); const float rs = rsl[tl];
                    v2u w; w.x = cvtpk(v[0] * rs, v[1] * rs); w.y = cvtpk(v[2] * rs, v[3] * rs);
                    *(v2u*)(upsb + (size_t)(t0 + tl) * NUP + n0 + 8 * rg + 4 * (lane >> 5)) = w;
                    __syncthreads(); }
            }
            SEAM(pb + 3);
        }
        if (IN(5)) { DERIVE()
            constexpr int NCG = DFF / 8, NFIX = 112 * NCG, NSMP = MS * NCG;
            const float* fcw = AIN(I_FCW) + (size_t)l * 3 * NUP;
            for (int task = bx * 512 + tid; task < NFIX + NSMP; task += G * 512) {
                const bool smp = task >= NFIX; const int tk = smp ? task - NFIX : task; const int q = tk / NCG, ch = (tk % NCG) * 8;
                const int ic = 256 * (ch >> 7) + (ch & 127);
                float wg[3][8], wv[3][8];
#pragma unroll
                for (int j = 0; j < 3; ++j) { const f32x4 a0 = *(const f32x4*)(fcw + j * NUP + ch), a1 = *(const f32x4*)(fcw + j * NUP + ch + 4), c0 = *(const f32x4*)(fcw + j * NUP + DFF + ch), c1 = *(const f32x4*)(fcw + j * NUP + DFF + ch + 4);
#pragma unroll
                    for (int e = 0; e < 4; ++e) { wg[j][e] = a0[e]; wg[j][4 + e] = a1[e]; wv[j][e] = c0[e]; wv[j][4 + e] = c1[e]; } }
                if (!smp) {
                    float gh[2][8], vh[2][8];
                    const int pm = (q / 7) * 8 + (q % 7) + 1;
#pragma unroll
                    for (int j = 0; j < 2; ++j) { const float* tp = tailf + (size_t)((pm - 1) * 2 + j) * NUP + ic; const f32x4 a0 = *(const f32x4*)tp, a1 = *(const f32x4*)(tp + 4), c0 = *(const f32x4*)(tp + 128), c1 = *(const f32x4*)(tp + 132);
#pragma unroll
                        for (int e = 0; e < 4; ++e) { gh[j][e] = a0[e]; gh[j][4 + e] = a1[e]; vh[j][e] = c0[e]; vh[j][4 + e] = c1[e]; } }
#pragma unroll
                    for (int r = 0; r < 2; ++r) { const float* hp = headf + (size_t)(pm * 2 + r) * NUP + ic; const f32x4 a0 = *(const f32x4*)hp, a1 = *(const f32x4*)(hp + 4), c0 = *(const f32x4*)(hp + 128), c1 = *(const f32x4*)(hp + 132);
                        float gg[8] = {a0[0], a0[1], a0[2], a0[3], a1[0], a1[1], a1[2], a1[3]}, vv[8] = {c0[0], c0[1], c0[2], c0[3], c1[0], c1[1], c1[2], c1[3]}; float o[8];
#pragma unroll
                        for (int e = 0; e < 8; ++e) { const float Gc = wg[0][e] * gh[0][e] + wg[1][e] * gh[1][e] + wg[2][e] * gg[e]; const float Vc = wv[0][e] * vh[0][e] + wv[1][e] * vh[1][e] + wv[2][e] * vv[e];
                            o[e] = silu_f(Gc) * Vc; gh[0][e] = gh[1][e]; gh[1][e] = gg[e]; vh[0][e] = vh[1][e]; vh[1][e] = vv[e]; }
                        v4u w; w.x = pk2(o[0], o[1]); w.y = pk2(o[2], o[3]); w.z = pk2(o[4], o[5]); w.w = pk2(o[6], o[7]);
                        *(v4u*)(actb + (size_t)(pm * 256 + r) * DFF + ch) = w; }
                } else {
                    const int b = q >> 5, r = q & 31;
                    float xg[3][8], xv[3][8];
#pragma unroll
                    for (int j = 0; j < 3; ++j) { const int rr = r - 2 + j;
                        if (rr >= 0) { const bf16* rp = upsb + (size_t)(b * ST + rr) * NUP + ic; const v4u a = *(const v4u*)rp, c = *(const v4u*)(rp + 128);
                            xg[j][0] = bflo(a.x); xg[j][1] = bfhi(a.x); xg[j][2] = bflo(a.y); xg[j][3] = bfhi(a.y); xg[j][4] = bflo(a.z); xg[j][5] = bfhi(a.z); xg[j][6] = bflo(a.w); xg[j][7] = bfhi(a.w);
                            xv[j][0] = bflo(c.x); xv[j][1] = bfhi(c.x); xv[j][2] = bflo(c.y); xv[j][3] = bfhi(c.y); xv[j][4] = bflo(c.z); xv[j][5] = bfhi(c.z); xv[j][6] = bflo(c.w); xv[j][7] = bfhi(c.w); }
                        else { const float* st = AIN(I_SFFN) + (size_t)((b * 2 + l) * 2 + (rr + 2)) * NUP; const f32x4 a0 = *(const f32x4*)(st + ch), a1 = *(const f32x4*)(st + ch + 4), c0 = *(const f32x4*)(st + DFF + ch), c1 = *(const f32x4*)(st + DFF + ch + 4);
#pragma unroll
                            for (int e = 0; e < 4; ++e) { xg[j][e] = a0[e]; xg[j][4 + e] = a1[e]; xv[j][e] = c0[e]; xv[j][4 + e] = c1[e]; } } }
                    float o[8];
#pragma unroll
                    for (int e = 0; e < 8; ++e) { const float Gc = wg[0][e] * xg[0][e] + wg[1][e] * xg[1][e] + wg[2][e] * xg[2][e]; const float Vc = wv[0][e] * xv[0][e] + wv[1][e] * xv[1][e] + wv[2][e] * xv[2][e]; o[e] = silu_f(Gc) * Vc; }
                    v4u w; w.x = pk2(o[0], o[1]); w.y = pk2(o[2], o[3]); w.z = pk2(o[4], o[5]); w.w = pk2(o[6], o[7]);
                    *(v4u*)(actb + (size_t)(MP + b * ST + r) * DFF + ch) = w;
                    if (r >= ST - 2) { float* sp = out + O_SF + (size_t)((b * 2 + l) * 2 + (r - (ST - 2))) * NUP + ch;
                        *(f32x4*)sp = (f32x4){xg[2][0], xg[2][1], xg[2][2], xg[2][3]}; *(f32x4*)(sp + 4) = (f32x4){xg[2][4], xg[2][5], xg[2][6], xg[2][7]};
                        *(f32x4*)(sp + DFF) = (f32x4){xv[2][0], xv[2][1], xv[2][2], xv[2][3]}; *(f32x4*)(sp + DFF + 4) = (f32x4){xv[2][4], xv[2][5], xv[2][6], xv[2][7]}; }
                }
            }
            SEAM(pb + 4);
        }
        if (IN(pb + 5)) { DERIVE()
            pg8::Gemm g{actb, Wdn_t + (size_t)l * DM * DFF, MP, DM, DFF, DFF}; pg8::StaticOrder S; S.init(MP, DM, G, bx);
            if (l == 1 && G == 256) { pg8::EpiFinal Ef{{}, xb, out, AIN(I_GFIN), ssqB + (size_t)8 * MT, ctl + CW_PANEL, aux}; pg8::gemm_phase<pg8::EpiFinal, true, true>(L, g, S, Ef, wave); }
            else { pg8::EpiRes E{{}, xb, xb, ssqA, aux}; pg8::gemm_phase<pg8::EpiRes, true, true>(L, g, S, E, wave); }
            {
                LAS float* red = (LAS float*)(L + SG_AUX);
                for (int su = bx; su < 128; su += G) { const int t0 = (su & 3) * 64, cb = su >> 2, n0 = cb * 32;
                    f32x16 acc1[1]; sg_accumulate<1, 11>(actb + (size_t)MP * DFF, DFF, Wdn_t + (size_t)l * DM * DFF, DFF, t0 + 32 * (wave >> 2), n0, 11 * (wave & 3), L + wave * SG_STG, lane, acc1);
                    const f32x4 v = sg_reduce<1, 4>(acc1, wave, L, lane, 0, wave & 3, (wave >> 2) * 4, true);
                    sres_epilogue<2>(true, v, t0, n0, cb, wave >> 2, wave & 3, lane, tid, xb + (size_t)MP * DM, ssqSA, red); }
            }
            SEAM(pb + 5);
        }
    }
    if (IN(13)) { DERIVE()
        const float* gf = AIN(I_GFIN);
        for (int m = (G == 256 ? MP : 0) + gw; m < MT; m += NGW) {
            float s = 0.f; if (m < MP) { if (lane < 4) s = ssqA[(size_t)lane * MT + m]; } else if (lane < 32) s = ssqSA[lane * 256 + (m - MP)];
            s = wave_sum(s); const float rs = __builtin_amdgcn_rsqf(s * (1.0f / DM) + EPS);
            const GAS v2u* xin = (const GAS v2u*)(xb + (size_t)m * DM) + lane; GAS f32x4* y4 = (GAS f32x4*)(out + (size_t)m * DM) + lane; const f32x4* g4 = (const f32x4*)gf + lane;
#pragma unroll
            for (int j = 0; j < 4; ++j) { const v2u w = xin[64 * j]; const f32x4 gg = g4[64 * j]; y4[64 * j] = (f32x4){bflo(w.x) * rs * gg.x, bfhi(w.x) * rs * gg.y, bflo(w.y) * rs * gg.z, bfhi(w.y) * rs * gg.w}; }
        }
    }
#undef IN
#undef SEAM
}

extern "C" void kernel_launch(void* const* d_in, const int* in_sizes, int n_in, void* d_out, int out_size, void* d_ws, size_t ws_size, hipStream_t stream) {
    static int grid = 0;
    if (grid == 0) {
        if (n_in != 23 || in_sizes[0] != MP * DM || (size_t)out_size != O_END || ws_size < WS_END) { fprintf(stderr, "kernel_launch: unexpected shapes: n_in %d in0 %d out %d ws %zu\n", n_in, n_in > 0 ? in_sizes[0] : -1, out_size, ws_size); grid = -1; return; }
        int dev = 0, cus = 0;
        if (hipGetDevice(&dev) != hipSuccess || hipDeviceGetAttribute(&cus, hipDeviceAttributeMultiprocessorCount, dev) != hipSuccess) { grid = -1; return; }
        if (hipFuncSetAttribute((const void*)trunk_fwd, hipFuncAttributeMaxDynamicSharedMemorySize, LDS_BYTES) != hipSuccess) { fprintf(stderr, "kernel_launch: hipFuncSetAttribute failed\n"); grid = -1; return; }
        int per_cu = 0;
        if (hipOccupancyMaxActiveBlocksPerMultiprocessor(&per_cu, (const void*)trunk_fwd, 512, LDS_BYTES) != hipSuccess || per_cu < 1) fprintf(stderr, "kernel_launch: occupancy query reports %d\n", per_cu);
        (void)hipGetLastError();
        grid = cus;
    }
    if (grid < 0) return;
    (void)hipMemsetAsync((char*)d_ws + WS_CTL, 0, CTL_ZERO_BYTES, stream);
    Args a{};
    for (int i = 0; i < 23; ++i) a.in[i] = (const float*)d_in[i];
    a.out = (float*)d_out; a.ws = (unsigned char*)d_ws;
    hipLaunchKernelGGL(trunk_fwd, dim3(grid), dim3(512), LDS_BYTES, stream, a);
}
```

```cpp
#include <hip/hip_runtime.h>
#include <cstdio>
#include <cstdint>

constexpr int DM = 1024, NB = 16, SEQ = 2048, MP = NB * SEQ, SB = 8, ST = 32, MS = SB * ST, MT = MP + MS;
constexpr int NPROJ = 2048, DFF = 2816, NUP = 2 * DFF, WIN = 128;
constexpr float EPS = 1e-6f;
constexpr int ZQ = 0, ZK = 256, ZV = 384, ZCB = 512, ZCC = 768, ZCH = 1024, ZGU = 1280, ZGV = 1536, ZPI = 1792;
constexpr size_t O_YP = 0, O_YS = 33554432, O_PK = 33816576, O_PV = 34340864, O_PC = 34865152, O_PP = 34881536, O_PF = 35004416,
                 O_SK = 35364864, O_SV = 35430400, O_SC = 35495936, O_SP = 35504128, O_SF = 35565568, O_SG = 35745792, O_END = 35876864;

__device__ __forceinline__ int lane_id() { int l; asm volatile("v_mbcnt_lo_u32_b32 %0, -1, 0\n\tv_mbcnt_hi_u32_b32 %0, -1, %0" : "=v"(l)); return l; }
namespace pg8 {
#define PG8_LAS __attribute__((address_space(3)))
typedef unsigned short bf16_t;
typedef short bf16x8 __attribute__((ext_vector_type(8)));
typedef float f32x4 __attribute__((ext_vector_type(4)));
typedef unsigned u32x4 __attribute__((ext_vector_type(4)));
constexpr int BM = 256, BK = 64, HALF = 128, HTB = HALF * BK * 2, STAGE_BYTES = 8 * HTB, NXCD = 8, WGM = 8;

__host__ __device__ __forceinline__ int lds_byte(int r, int c) { const int st = (r >> 4) * 2 + (c >> 5), rr = r & 15, cc = c & 31, ob = rr * 64 + cc * 2; return st * 1024 + (ob ^ (((ob >> 9) & 1) << 5)); }
__host__ __device__ __forceinline__ void stage_rc(int b, int& R, int& C) { const int st = b / 1024, sb = b % 1024, swz = sb ^ (((sb >> 9) & 1) << 5); R = (st >> 1) * 16 + swz / 64; C = (st & 1) * 32 + (swz % 64) / 2; }
__host__ __device__ __forceinline__ int perm32(int rho) { const int n = rho >> 4, i = rho & 15; return 8 * (i >> 2) + 4 * n + (i & 3); }

struct Unit { int pm, pn; };
struct Gemm { const bf16_t* A; const bf16_t* Bt; int M, N, K, lda; };

struct StaticOrder {
    int nM, nN, nwg, G, c;
    __host__ __device__ void init(int M, int N, int G_, int c_) { nM = M / BM; nN = N / BM; nwg = nM * nN; G = G_; c = c_; }
    __host__ __device__ bool next(int i, Unit& u) const {
        const long L = (long)i * G + c; if (L >= nwg) return false;
        int wgid = (int)L; { const int q = nwg / NXCD, r = nwg % NXCD, xcd = wgid % NXCD, off = wgid / NXCD; wgid = (xcd < r ? xcd * (q + 1) : r * (q + 1) + (xcd - r) * q) + off; }
        const int nig = WGM * nN, gid = wgid / nig, fm = gid * WGM, gsz = (nM - fm) < WGM ? (nM - fm) : WGM;
        u.pm = fm + ((wgid % nig) % gsz); u.pn = (wgid % nig) / gsz; return true;
    }
};

__device__ __forceinline__ unsigned cvt_pk_bf16(float lo, float hi) { unsigned r; asm volatile("v_cvt_pk_bf16_f32 %0, %1, %2" : "=v"(r) : "v"(lo), "v"(hi)); return r; }

template <class Epi, bool ALIGN_EPI, bool SP2, bool AROW8 = false>
__device__ __forceinline__ void gemm_phase(PG8_LAS unsigned char* lds, const Gemm g, const StaticOrder& S, const Epi& E, int wid_s) {
    const int lane = lane_id(); const int wid = wid_s, tid = wid * 64 + lane, wr = wid >> 2, wc = wid & 3, fr = lane & 15, fq = lane >> 4;
    const int K = g.K, nt = K / BK, lda = g.lda;
    unsigned voffA[2], voffB[2];
#pragma unroll
    for (int i = 0; i < 2; ++i) { int R, C; stage_rc(tid * 16 + i * 8192, R, C); const int Rb = Epi::PERM ? ((R & ~31) + perm32(R & 31)) : R;
        voffA[i] = (unsigned)((AROW8 ? (128 * (R >> 6) + 8 * (R & 15) + ((R >> 4) & 3)) : (128 * (R >> 6) + (R & 63))) * lda + C) * 2u; voffB[i] = (unsigned)(Rb * K + C) * 2u; }
    const size_t kstep = (size_t)(BK * 2);
    const size_t hstepA = (size_t)(AROW8 ? 4 : 64) * lda * 2, hstepB = (size_t)HALF * K * 2;
    const size_t tstepA = (size_t)BM * lda * 2, tstepB = 2 * hstepB;
    const unsigned ldsw = (unsigned)wid * 1024u;
    const int aoff = lds_byte(wr * 64 + fr, fq * 8), boff = lds_byte(wc * 32 + fr, fq * 8);
#define PG8_SA(b, h) (((b) * 2 + (h)) * HTB)
#define PG8_SB(b, h) ((4 + (b) * 2 + (h)) * HTB)
#define PG8_STAGE(bufoff, gbase, voff) do { _Pragma("unroll") for (int _i = 0; _i < 2; ++_i) \
        __builtin_amdgcn_global_load_lds((const unsigned*)((const char*)(gbase) + (voff)[_i]), (PG8_LAS unsigned*)(lds + (bufoff) + ldsw + _i * 8192), 16, 0, 0); } while (0)
#define PG8_LDA(dst, b, h) do { _Pragma("unroll") for (int m = 0; m < 4; ++m) _Pragma("unroll") for (int k = 0; k < 2; ++k) dst[m][k] = *(const PG8_LAS bf16x8*)(lds + PG8_SA(b, h) + aoff + m * 2048 + k * 1024); } while (0)
#define PG8_LDB(dst, b, h) do { _Pragma("unroll") for (int n = 0; n < 2; ++n) _Pragma("unroll") for (int k = 0; k < 2; ++k) dst[n][k] = *(const PG8_LAS bf16x8*)(lds + PG8_SB(b, h) + boff + n * 2048 + k * 1024); } while (0)
#define PG8_MMA(ai, bj, At, Bt) do { __builtin_amdgcn_s_setprio(1); _Pragma("unroll") for (int m = 0; m < 4; ++m) _Pragma("unroll") for (int n = 0; n < 2; ++n) _Pragma("unroll") for (int k = 0; k < 2; ++k) \
        acc[ai][bj][m][n] = __builtin_amdgcn_mfma_f32_16x16x32_bf16(Bt[n][k], At[m][k], acc[ai][bj][m][n], 0, 0, 0); __builtin_amdgcn_s_setprio(0); } while (0)
#define PG8_WAIT_V(n) asm volatile("s_waitcnt vmcnt(" #n ")" ::: "memory")
#define PG8_WAIT_L(n) asm volatile("s_waitcnt lgkmcnt(" #n ")" ::: "memory")
#define PG8_BAR __builtin_amdgcn_s_barrier()
#define PG8_SCHED __builtin_amdgcn_sched_barrier(0)
    Unit cur, nxt; int ui = 0;
    if (!S.next(0, cur)) return;
    f32x4 acc[2][2][4][2];
    typename Epi::InitT ini; E.init_load(ini, cur, wr, wc);
    bf16x8 At[4][2], B0[2][2], B1[2][2];
    const char* cA = (const char*)g.A + (size_t)cur.pm * tstepA; const char* cB = (const char*)g.Bt + (size_t)cur.pn * tstepB;
    E.prep(cur, 0, wid, lane);
    if constexpr (SP2) {
        PG8_STAGE(PG8_SB(0, 0), cB, voffB); PG8_STAGE(PG8_SB(0, 1), cB + hstepB, voffB); PG8_STAGE(PG8_SA(0, 0), cA, voffA); PG8_STAGE(PG8_SA(0, 1), cA + hstepA, voffA);
        if (wr == 1) PG8_BAR;
        PG8_WAIT_V(2); PG8_BAR;
        PG8_STAGE(PG8_SB(1, 0), cB + kstep, voffB); PG8_STAGE(PG8_SA(1, 0), cA + kstep, voffA); PG8_STAGE(PG8_SB(1, 1), cB + hstepB + kstep, voffB);
        PG8_WAIT_V(6); PG8_BAR;
    } else {
        PG8_STAGE(PG8_SB(0, 0), cB, voffB); PG8_STAGE(PG8_SA(0, 0), cA, voffA); PG8_STAGE(PG8_SB(0, 1), cB + hstepB, voffB); PG8_STAGE(PG8_SA(0, 1), cA + hstepA, voffA);
        if (wr == 1) PG8_BAR;
        PG8_WAIT_V(4); PG8_BAR;
        PG8_STAGE(PG8_SB(1, 0), cB + kstep, voffB); PG8_STAGE(PG8_SA(1, 0), cA + kstep, voffA); PG8_STAGE(PG8_SB(1, 1), cB + hstepB + kstep, voffB);
        PG8_WAIT_V(6); PG8_BAR;
    }
    E.init_finish(acc, ini);
    for (;;) {
        const bool has_next = S.next(ui + 1, nxt);
        const char* nA = has_next ? (const char*)g.A + (size_t)nxt.pm * tstepA : cA; const char* nB = has_next ? (const char*)g.Bt + (size_t)nxt.pn * tstepB : cB;
        for (int t = 0; t < nt; t += 2) {
            const bool last = (t == nt - 2);
            const char* a1 = cA + (size_t)(t + 1) * kstep;
            const char* a2 = last ? nA : cA + (size_t)(t + 2) * kstep; const char* b2 = last ? nB : cB + (size_t)(t + 2) * kstep;
            const char* a3 = a2 + kstep; const char* b3 = b2 + kstep;
            if (last && has_next) E.prep(nxt, ui + 1, wid, lane);
            if constexpr (SP2) {
            PG8_LDB(B0, 0, 0); PG8_LDB(B1, 0, 1); PG8_SCHED; PG8_LDA(At, 0, 0); PG8_STAGE(PG8_SA(1, 1), a1 + hstepA, voffA);
            PG8_WAIT_V(8); PG8_WAIT_L(0); PG8_BAR; PG8_MMA(0, 0, At, B0); PG8_MMA(0, 1, At, B1); PG8_BAR; PG8_SCHED;
            PG8_LDA(At, 0, 1); PG8_STAGE(PG8_SB(0, 0), b2, voffB); PG8_STAGE(PG8_SB(0, 1), b2 + hstepB, voffB); PG8_STAGE(PG8_SA(0, 0), a2, voffA);
            PG8_WAIT_V(8); PG8_WAIT_L(0); PG8_BAR; PG8_MMA(1, 0, At, B0); PG8_MMA(1, 1, At, B1); PG8_BAR; PG8_SCHED;
            PG8_LDB(B0, 1, 0); PG8_LDB(B1, 1, 1); PG8_SCHED; PG8_LDA(At, 1, 0); PG8_STAGE(PG8_SA(0, 1), a2 + hstepA, voffA);
            PG8_WAIT_V(8); PG8_WAIT_L(0); PG8_BAR; PG8_MMA(0, 0, At, B0); PG8_MMA(0, 1, At, B1); PG8_BAR; PG8_SCHED;
            PG8_LDA(At, 1, 1); PG8_STAGE(PG8_SB(1, 0), b3, voffB); PG8_STAGE(PG8_SB(1, 1), b3 + hstepB, voffB); PG8_STAGE(PG8_SA(1, 0), a3, voffA);
            PG8_WAIT_V(8); PG8_WAIT_L(0); PG8_BAR; PG8_MMA(1, 0, At, B0); PG8_MMA(1, 1, At, B1); PG8_BAR; PG8_SCHED;
            } else {
            PG8_LDB(B0, 0, 0); PG8_SCHED; PG8_LDA(At, 0, 0); PG8_STAGE(PG8_SA(1, 1), a1 + hstepA, voffA);
            PG8_WAIT_L(8); PG8_BAR; PG8_WAIT_L(0); PG8_MMA(0, 0, At, B0); PG8_BAR; PG8_SCHED;
            PG8_LDB(B1, 0, 1); PG8_STAGE(PG8_SB(0, 0), b2, voffB);
            PG8_BAR; PG8_WAIT_L(0); PG8_MMA(0, 1, At, B1); PG8_BAR;
            PG8_LDA(At, 0, 1); PG8_STAGE(PG8_SA(0, 0), a2, voffA);
            PG8_BAR; PG8_WAIT_L(0); PG8_MMA(1, 0, At, B0); PG8_BAR; PG8_SCHED;
            PG8_STAGE(PG8_SB(0, 1), b2 + hstepB, voffB);
            PG8_WAIT_V(6); PG8_BAR; PG8_MMA(1, 1, At, B1); PG8_BAR;
            PG8_LDB(B0, 1, 0); PG8_SCHED; PG8_LDA(At, 1, 0); PG8_STAGE(PG8_SA(0, 1), a2 + hstepA, voffA);
            PG8_WAIT_L(8); PG8_BAR; PG8_WAIT_L(0); PG8_MMA(0, 0, At, B0); PG8_BAR; PG8_SCHED;
            PG8_LDB(B1, 1, 1); PG8_STAGE(PG8_SB(1, 0), b3, voffB);
            PG8_BAR; PG8_WAIT_L(0); PG8_MMA(0, 1, At, B1); PG8_BAR;
            PG8_LDA(At, 1, 1); PG8_STAGE(PG8_SA(1, 0), a3, voffA);
            PG8_BAR; PG8_WAIT_L(0); PG8_MMA(1, 0, At, B0); PG8_BAR; PG8_SCHED;
            PG8_STAGE(PG8_SB(1, 1), b3 + hstepB, voffB);
            PG8_WAIT_V(6); PG8_BAR; PG8_MMA(1, 1, At, B1); PG8_BAR;
            }
        }
        if constexpr (ALIGN_EPI) { if (wr == 0) PG8_BAR; }
        E(acc, cur, ui, wr, wc, fr, fq);
        if (!has_next) break;
        E.init_load(ini, nxt, wr, wc); E.init_finish(acc, ini);
        cur = nxt; cA = nA; cB = nB; ++ui;
        if constexpr (ALIGN_EPI) { if (wr == 1) PG8_BAR; }
    }
    PG8_WAIT_V(0);
    if constexpr (!ALIGN_EPI) { if (wr == 0) PG8_BAR; }
    PG8_BAR;
#undef PG8_SA
#undef PG8_SB
#undef PG8_STAGE
#undef PG8_LDA
#undef PG8_LDB
#undef PG8_MMA
#undef PG8_WAIT_V
#undef PG8_WAIT_L
#undef PG8_BAR
#undef PG8_SCHED
}

struct ZeroInit {
    struct InitT {};
    __device__ __forceinline__ void init_load(InitT&, const Unit&, int, int) const {}
    __device__ __forceinline__ void init_finish(f32x4 (&acc)[2][2][4][2], const InitT&) const {
#pragma unroll
        for (int a = 0; a < 2; ++a)
#pragma unroll
            for (int b = 0; b < 2; ++b)
#pragma unroll
                for (int m = 0; m < 4; ++m)
#pragma unroll
                    for (int n = 0; n < 2; ++n) acc[a][b][m][n] = (f32x4){0.f, 0.f, 0.f, 0.f};
    }
};
struct ResidInit {
    struct InitT { u32x4 r[2][4][2]; };
    __device__ __forceinline__ void resid_load(InitT& it, const bf16_t* xin, const Unit& u, int wr, int wc) const {
        const int lane_ = lane_id(), fr = lane_ & 15, fq = lane_ >> 4; const int col0 = u.pn * BM + wc * 32 + 8 * fq;
#pragma unroll
        for (int ai = 0; ai < 2; ++ai)
#pragma unroll
            for (int m = 0; m < 4; ++m)
#pragma unroll
                for (int bj = 0; bj < 2; ++bj) it.r[ai][m][bj] = *(const u32x4*)(xin + (size_t)(u.pm * BM + wr * HALF + ai * 64 + m * 16 + fr) * DM + col0 + bj * HALF);
    }
    __device__ __forceinline__ void init_finish(f32x4 (&acc)[2][2][4][2], const InitT& it) const {
#pragma unroll
        for (int ai = 0; ai < 2; ++ai)
#pragma unroll
            for (int m = 0; m < 4; ++m)
#pragma unroll
                for (int bj = 0; bj < 2; ++bj) { const u32x4 r = it.r[ai][m][bj];
                    acc[ai][bj][m][0] = (f32x4){__builtin_bit_cast(float, r.x << 16), __builtin_bit_cast(float, r.x & 0xffff0000u), __builtin_bit_cast(float, r.y << 16), __builtin_bit_cast(float, r.y & 0xffff0000u)};
                    acc[ai][bj][m][1] = (f32x4){__builtin_bit_cast(float, r.z << 16), __builtin_bit_cast(float, r.z & 0xffff0000u), __builtin_bit_cast(float, r.w << 16), __builtin_bit_cast(float, r.w & 0xffff0000u)}; }
    }
};
template <int MODE> struct EpiRow : ZeroInit {
    static constexpr bool PERM = true;
    bf16_t* O; int ldc; const float* ssq; int nparts; PG8_LAS float* aux; const float* rope; PG8_LAS unsigned char* stg;
    __device__ __forceinline__ void prep(const Unit& u, int ui, int wid, int) const {
        const int lane = lane_id();
        if (wid < 4) {
#pragma unroll
            for (int p = 0; p < 4; ++p)
            __builtin_amdgcn_global_load_lds((const unsigned*)(ssq + (size_t)p * MT + u.pm * BM + wid * 64 + lane), (PG8_LAS unsigned*)(aux + ((ui & 1) * 4 + p) * 256 + wid * 64), 4, 0, 0); }
    }
    __device__ __forceinline__ void operator()(const f32x4 (&acc)[2][2][4][2], const Unit& u, int ui, int wr, int wc, int, int) const {
        const int lane_ = lane_id(), fr = lane_ & 15, fq = lane_ >> 4;
        const PG8_LAS float* ax = aux + (ui & 1) * 1024;
        PG8_LAS unsigned char* sw = stg + (wr * 4 + wc) * 1280 + fr * 80 + fq * 16; const PG8_LAS unsigned char* sr = stg + (wr * 4 + wc) * 1280 + (lane_ >> 2) * 80 + (lane_ & 3) * 16;
#pragma unroll
        for (int ai = 0; ai < 2; ++ai)
#pragma unroll
            for (int m = 0; m < 4; ++m) {
                const int rl = wr * HALF + ai * 64 + m * 16 + fr; const int row = u.pm * BM + rl; const float ssum = (ax[rl] + ax[256 + rl]) + (ax[512 + rl] + ax[768 + rl]); const float rs = __builtin_amdgcn_rsqf(ssum * (1.0f / DM) + EPS);
                bf16_t* rowp = O + (size_t)(u.pm * BM + wr * HALF + ai * 64 + m * 16 + (lane_ >> 2)) * ldc + u.pn * BM + wc * 32 + 8 * (lane_ & 3);
                f32x4 cs[4];
                const bool dorope = (MODE == 1) && (u.pn <= 1) && ((wc & 1) == 0);
                if (MODE == 1) { if (dorope && fq < 2) { const int pos = row < MP ? (row & (SEQ - 1)) : (SEQ + ((row - MP) & (ST - 1))); const f32x4* rp = (const f32x4*)(rope + (size_t)pos * 16);
                    cs[0] = rp[0]; cs[1] = rp[1]; cs[2] = rp[2]; cs[3] = rp[3]; } else { cs[0] = cs[1] = cs[2] = cs[3] = (f32x4){1.f, 0.f, 1.f, 0.f}; } }
#pragma unroll
                for (int bj = 0; bj < 2; ++bj) {
                    f32x4 v0 = acc[ai][bj][m][0] * rs, v1 = acc[ai][bj][m][1] * rs;
                    if (MODE == 1) { if (dorope && (u.pn == 0 || bj == 0)) {
                        f32x4 o0, o1;
#pragma unroll
                        for (int e = 0; e < 4; ++e) { o0[e] = __shfl_xor(v0[e], 16); o1[e] = __shfl_xor(v1[e], 16); }
                        if (fq < 2) { const float sg = fq == 0 ? -1.f : 1.f;
                            v0 = (f32x4){v0[0] * cs[0][0] + sg * o0[0] * cs[0][1], v0[1] * cs[0][2] + sg * o0[1] * cs[0][3], v0[2] * cs[1][0] + sg * o0[2] * cs[1][1], v0[3] * cs[1][2] + sg * o0[3] * cs[1][3]};
                            v1 = (f32x4){v1[0] * cs[2][0] + sg * o1[0] * cs[2][1], v1[1] * cs[2][2] + sg * o1[1] * cs[2][3], v1[2] * cs[3][0] + sg * o1[2] * cs[3][1], v1[3] * cs[3][2] + sg * o1[3] * cs[3][3]}; }
                    } }
                    u32x4 w; w.x = cvt_pk_bf16(v0[0], v0[1]); w.y = cvt_pk_bf16(v0[2], v0[3]); w.z = cvt_pk_bf16(v1[0], v1[1]); w.w = cvt_pk_bf16(v1[2], v1[3]);
                    *(PG8_LAS u32x4*)sw = w; const u32x4 w2 = *(const PG8_LAS u32x4*)sr; *(u32x4*)(rowp + bj * HALF) = w2;
                }
            }
    }
};
__device__ __forceinline__ float dpp_ror1(float v) { return __builtin_bit_cast(float, __builtin_amdgcn_mov_dpp(__builtin_bit_cast(int, v), 0x121, 0xf, 0xf, true)); }
__device__ __forceinline__ float dpp_ror2(float v) { return __builtin_bit_cast(float, __builtin_amdgcn_mov_dpp(__builtin_bit_cast(int, v), 0x122, 0xf, 0xf, true)); }
__device__ __forceinline__ float ua_shr1(float old, float v) { asm volatile("s_nop 1\n\tv_mov_b32_dpp %0, %1 row_shr:1 row_mask:0xf bank_mask:0xf" : "+v"(old) : "v"(v)); return old; }
struct EpiUpAct : ZeroInit {
    static constexpr bool PERM = true;
    bf16_t* act; const float* ssq; int nparts; PG8_LAS float* aux; PG8_LAS f32x4* xch; PG8_LAS float* wl; const float* fcw; float* head; float* tail; float* fout;
    __device__ __forceinline__ void prep(const Unit& u, int ui, int wid, int) const {
        const int lane = lane_id();
        if (wid < 4) {
#pragma unroll
            for (int p = 0; p < 4; ++p)
            __builtin_amdgcn_global_load_lds((const unsigned*)(ssq + (size_t)p * MT + u.pm * BM + wid * 64 + lane), (PG8_LAS unsigned*)(aux + ((ui & 1) * 4 + p) * 256 + wid * 64), 4, 0, 0); }
        else {
#pragma unroll
            for (int k = 0; k < 3; ++k) { const int c = (wid - 4) * 3 + k, j = c >> 2, bj = (c >> 1) & 1, hf = c & 1;
                __builtin_amdgcn_global_load_lds((const unsigned*)(fcw + (size_t)j * NUP + bj * DFF + u.pn * HALF + hf * 64 + lane), (PG8_LAS unsigned*)(wl + (ui & 1) * 768 + c * 64), 4, 0, 0); } }
    }
    __device__ __forceinline__ void operator()(const f32x4 (&acc)[2][2][4][2], const Unit& u, int ui, int wr, int wc, int, int) const {
        typedef float f32x2 __attribute__((ext_vector_type(2)));
        const int lane_ = lane_id(), fr = lane_ & 15, fq = lane_ >> 4;
        const PG8_LAS float* ax = aux + (ui & 1) * 1024; const PG8_LAS float* wq = wl + (ui & 1) * 768;
        float rs[8];
        { const int rl = wr * HALF + 8 * fr;
#pragma unroll
          for (int h = 0; h < 2; ++h) { const f32x4 p0 = *(const PG8_LAS f32x4*)(ax + rl + 4 * h), p1 = *(const PG8_LAS f32x4*)(ax + 256 + rl + 4 * h), p2 = *(const PG8_LAS f32x4*)(ax + 512 + rl + 4 * h), p3 = *(const PG8_LAS f32x4*)(ax + 768 + rl + 4 * h);
#pragma unroll
              for (int k = 0; k < 4; ++k) rs[4 * h + k] = __builtin_amdgcn_rsqf(((p0[k] + p1[k]) + (p2[k] + p3[k])) * (1.0f / DM) + EPS); } }
        const int cl = wc * 32 + 8 * fq;
        if (fr == 15) {
#pragma unroll
            for (int bj = 0; bj < 2; ++bj)
#pragma unroll
                for (int n = 0; n < 2; ++n)
#pragma unroll
                    for (int k = 0; k < 2; ++k) { const f32x4 x = acc[1][bj][2 + k][n] * rs[6 + k];
                        if (wr == 0) xch[((bj * 4 + wc) * 2 + n) * 8 + fq * 2 + k] = x;
                        else { *(f32x4*)(tail + (size_t)(u.pm * 2 + k) * NUP + u.pn * BM + bj * HALF + cl + 4 * n) = x;
                            if ((u.pm & 7) == 7) *(f32x4*)(fout + (size_t)((u.pm >> 3) * 4 + k) * NUP + bj * DFF + u.pn * HALF + cl + 4 * n) = x; } }
        }
        if (fr == 0 && wr == 0) {
#pragma unroll
            for (int bj = 0; bj < 2; ++bj)
#pragma unroll
                for (int n = 0; n < 2; ++n)
#pragma unroll
                    for (int k = 0; k < 2; ++k) *(f32x4*)(head + (size_t)(u.pm * 2 + k) * NUP + u.pn * BM + bj * HALF + cl + 4 * n) = acc[0][bj][k][n] * rs[k];
        }
        asm volatile("s_waitcnt lgkmcnt(0)" ::: "memory"); __builtin_amdgcn_s_barrier(); asm volatile("" ::: "memory");
        bf16_t* arow = act + (size_t)(u.pm * BM + wr * HALF + 8 * fr) * DFF + u.pn * HALF + cl;
        unsigned pk0[8][2];
#define UA_SHR1(old_, v_) ua_shr1((old_), (v_))
#pragma unroll
        for (int n = 0; n < 2; ++n) {
            f32x4 wg[3], wv[3];
#pragma unroll
            for (int j = 0; j < 3; ++j) { wg[j] = *(const PG8_LAS f32x4*)(wq + (j * 2 + 0) * 128 + cl + 4 * n); wv[j] = *(const PG8_LAS f32x4*)(wq + (j * 2 + 1) * 128 + cl + 4 * n); }
            f32x4 hg6 = (f32x4){0.f, 0.f, 0.f, 0.f}, hg7 = hg6, hv6 = hg6, hv7 = hg6;
            if (wr == 1 && fr == 0) { hg6 = xch[((0 * 4 + wc) * 2 + n) * 8 + fq * 2 + 0]; hg7 = xch[((0 * 4 + wc) * 2 + n) * 8 + fq * 2 + 1];
                                      hv6 = xch[((1 * 4 + wc) * 2 + n) * 8 + fq * 2 + 0]; hv7 = xch[((1 * 4 + wc) * 2 + n) * 8 + fq * 2 + 1]; }
            unsigned pkn[8][2];
#pragma unroll
            for (int ep = 0; ep < 2; ++ep) {
                const int e0 = 2 * ep, e1 = 2 * ep + 1;
                f32x2 xg[8], xv[8];
#pragma unroll
                for (int blk = 0; blk < 8; ++blk) { const f32x4 ag = acc[blk >> 2][0][blk & 3][n], av = acc[blk >> 2][1][blk & 3][n];
                    xg[blk] = (f32x2){ag[e0], ag[e1]} * rs[blk]; xv[blk] = (f32x2){av[e0], av[e1]} * rs[blk]; }
                const f32x2 sg7 = (f32x2){UA_SHR1(hg7[e0], xg[7][0]), UA_SHR1(hg7[e1], xg[7][1])}, sg6 = (f32x2){UA_SHR1(hg6[e0], xg[6][0]), UA_SHR1(hg6[e1], xg[6][1])};
                const f32x2 sv7 = (f32x2){UA_SHR1(hv7[e0], xv[7][0]), UA_SHR1(hv7[e1], xv[7][1])}, sv6 = (f32x2){UA_SHR1(hv6[e0], xv[6][0]), UA_SHR1(hv6[e1], xv[6][1])};
                const f32x2 g2 = (f32x2){wg[2][e0], wg[2][e1]}, g1 = (f32x2){wg[1][e0], wg[1][e1]}, g0 = (f32x2){wg[0][e0], wg[0][e1]};
                const f32x2 v2 = (f32x2){wv[2][e0], wv[2][e1]}, v1 = (f32x2){wv[1][e0], wv[1][e1]}, v0 = (f32x2){wv[0][e0], wv[0][e1]};
#pragma unroll
                for (int blk = 0; blk < 8; ++blk) {
                    const f32x2 pg1 = blk >= 1 ? xg[blk >= 1 ? blk - 1 : 0] : sg7, pg2 = blk >= 2 ? xg[blk >= 2 ? blk - 2 : 0] : (blk == 1 ? sg7 : sg6);
                    const f32x2 pv1 = blk >= 1 ? xv[blk >= 1 ? blk - 1 : 0] : sv7, pv2 = blk >= 2 ? xv[blk >= 2 ? blk - 2 : 0] : (blk == 1 ? sv7 : sv6);
                    const f32x2 yg = g2 * xg[blk] + g1 * pg1 + g0 * pg2;
                    const f32x2 yv = v2 * xv[blk] + v1 * pv1 + v0 * pv2;
                    const f32x2 t = yg * -1.4426950408889634f;
                    const f32x2 d = (f32x2){__builtin_amdgcn_exp2f(t[0]), __builtin_amdgcn_exp2f(t[1])} + 1.f;
                    const f32x2 a = yg * yv * (f32x2){__builtin_amdgcn_rcpf(d[0]), __builtin_amdgcn_rcpf(d[1])};
                    pkn[blk][ep] = cvt_pk_bf16(a[0], a[1]);
                }
            }
#pragma unroll
            for (int blk = 0; blk < 8; ++blk) {
                if (n == 0) { pk0[blk][0] = pkn[blk][0]; pk0[blk][1] = pkn[blk][1]; }
                else { u32x4 w; w.x = pk0[blk][0]; w.y = pk0[blk][1]; w.z = pkn[blk][0]; w.w = pkn[blk][1];
                    { bf16_t* sp_ = arow + (size_t)blk * DFF; asm volatile("global_store_dwordx4 %0, %1, off nt sc1\n\ts_nop 1" :: "v"(sp_), "v"(w) : "memory"); } }
            }
        }
#undef UA_SHR1
    }
};
struct EpiRes : ResidInit {
    static constexpr bool PERM = true;
    const bf16_t* xin; bf16_t* xout; float* ssq_out; PG8_LAS float* red;
    __device__ __forceinline__ void prep(const Unit&, int, int, int) const {}
    __device__ __forceinline__ void init_load(InitT& it, const Unit& u, int wr, int wc) const { resid_load(it, xin, u, wr, wc); }
    __device__ __forceinline__ void operator()(const f32x4 (&acc)[2][2][4][2], const Unit& u, int ui, int wr, int wc, int, int) const {
        const int lane_ = lane_id(), fr = lane_ & 15, fq = lane_ >> 4;
        const int col0 = u.pn * BM + wc * 32 + 8 * fq;
#pragma unroll
        for (int ai = 0; ai < 2; ++ai) {
            const int rl0 = wr * HALF + ai * 64 + fr; const size_t off0 = (size_t)(u.pm * BM + rl0) * DM + col0;
#pragma unroll
            for (int m = 0; m < 4; ++m) {
                float sq = 0.f;
#pragma unroll
                for (int bj = 0; bj < 2; ++bj) {
                    const f32x4 v0 = acc[ai][bj][m][0], v1 = acc[ai][bj][m][1];
                    u32x4 w; w.x = cvt_pk_bf16(v0[0], v0[1]); w.y = cvt_pk_bf16(v0[2], v0[3]); w.z = cvt_pk_bf16(v1[0], v1[1]); w.w = cvt_pk_bf16(v1[2], v1[3]);
                    *(u32x4*)(xout + off0 + (size_t)m * 16 * DM + bj * HALF) = w;
                    const float q0 = __builtin_bit_cast(float, w.x << 16), q1 = __builtin_bit_cast(float, w.x & 0xffff0000u), q2 = __builtin_bit_cast(float, w.y << 16), q3 = __builtin_bit_cast(float, w.y & 0xffff0000u);
                    const float q4 = __builtin_bit_cast(float, w.z << 16), q5 = __builtin_bit_cast(float, w.z & 0xffff0000u), q6 = __builtin_bit_cast(float, w.w << 16), q7 = __builtin_bit_cast(float, w.w & 0xffff0000u);
                    sq += (q0 * q0 + q1 * q1) + (q2 * q2 + q3 * q3) + (q4 * q4 + q5 * q5) + (q6 * q6 + q7 * q7);
                }
                sq += __shfl_xor(sq, 16); sq += __shfl_xor(sq, 32);
                if (fq == 0) red[wc * 256 + rl0 + m * 16] = sq;
            }
        }
        asm volatile("s_waitcnt lgkmcnt(0)" ::: "memory"); __builtin_amdgcn_s_barrier(); asm volatile("" ::: "memory");
        if (wr == 0) { const int t = wc * 64 + lane_; ssq_out[(size_t)u.pn * MT + u.pm * BM + t] = (red[t] + red[256 + t]) + (red[512 + t] + red[768 + t]); }
    }
};
struct EpiFinal : ResidInit {
    static constexpr bool PERM = true;
    const bf16_t* xin; float* yout; const float* gfin; float* xbuf; unsigned* cnt; PG8_LAS float* red;
    __device__ __forceinline__ void prep(const Unit&, int, int, int) const {}
    __device__ __forceinline__ void init_load(InitT& it, const Unit& u, int wr, int wc) const { resid_load(it, xin, u, wr, wc); }
    __device__ __forceinline__ void operator()(const f32x4 (&acc)[2][2][4][2], const Unit& u, int ui, int wr, int wc, int, int) const {
        const int lane_ = lane_id(), fr = lane_ & 15, fq = lane_ >> 4;
        const int col0 = u.pn * BM + wc * 32 + 8 * fq;
        f32x4 gv[2][2];
#pragma unroll
        for (int bj = 0; bj < 2; ++bj) { gv[bj][0] = *(const f32x4*)(gfin + col0 + bj * HALF); gv[bj][1] = *(const f32x4*)(gfin + col0 + bj * HALF + 4); }
#define EF_X(ai, m, bj, v0, v1) const f32x4 v0 = acc[ai][bj][m][0], v1 = acc[ai][bj][m][1];
#pragma unroll
        for (int ai = 0; ai < 2; ++ai)
#pragma unroll
            for (int m = 0; m < 4; ++m) { float sq = 0.f;
#pragma unroll
                for (int bj = 0; bj < 2; ++bj) { EF_X(ai, m, bj, v0, v1)
                    sq += (v0[0] * v0[0] + v0[1] * v0[1]) + (v0[2] * v0[2] + v0[3] * v0[3]) + (v1[0] * v1[0] + v1[1] * v1[1]) + (v1[2] * v1[2] + v1[3] * v1[3]); }
                sq += __shfl_xor(sq, 16); sq += __shfl_xor(sq, 32);
                if (fq == 0) red[wc * 256 + wr * HALF + ai * 64 + m * 16 + fr] = sq; }
        asm volatile("s_waitcnt lgkmcnt(0)" ::: "memory"); __builtin_amdgcn_s_barrier(); asm volatile("" ::: "memory");
        const int t = wc * 64 + lane_;
        if (wr == 0) {
            const float sp = (red[t] + red[256 + t]) + (red[512 + t] + red[768 + t]);
            __hip_atomic_store(xbuf + (size_t)(u.pm * BM + t) * 4 + u.pn, sp, __ATOMIC_RELAXED, __HIP_MEMORY_SCOPE_AGENT);
            asm volatile("s_waitcnt vmcnt(0)" ::: "memory");
            if (lane_ == 0) __hip_atomic_fetch_add(cnt + 64 * u.pm, 1u, __ATOMIC_RELAXED, __HIP_MEMORY_SCOPE_AGENT);
            if (wc == 0) {
                unsigned spins = 0;
                while ((unsigned)__builtin_amdgcn_readfirstlane(__hip_atomic_load(cnt + 64 * u.pm, __ATOMIC_RELAXED, __HIP_MEMORY_SCOPE_AGENT)) < 16u) { __builtin_amdgcn_s_sleep(2); if (++spins > (1u << 22)) break; }
                __builtin_amdgcn_fence(__ATOMIC_ACQUIRE, "agent");
            }
        }
        asm volatile("s_waitcnt vmcnt(0) lgkmcnt(0)" ::: "memory"); __builtin_amdgcn_s_barrier(); asm volatile("" ::: "memory");
        if (wr == 0) {
            const float* sl = xbuf + (size_t)(u.pm * BM + t) * 4;
            const float tot = (__hip_atomic_load(sl, __ATOMIC_RELAXED, __HIP_MEMORY_SCOPE_AGENT) + __hip_atomic_load(sl + 1, __ATOMIC_RELAXED, __HIP_MEMORY_SCOPE_AGENT))
                            + (__hip_atomic_load(sl + 2, __ATOMIC_RELAXED, __HIP_MEMORY_SCOPE_AGENT) + __hip_atomic_load(sl + 3, __ATOMIC_RELAXED, __HIP_MEMORY_SCOPE_AGENT));
            red[t] = __builtin_amdgcn_rsqf(tot * (1.0f / DM) + EPS);
        }
        asm volatile("s_waitcnt lgkmcnt(0)" ::: "memory"); __builtin_amdgcn_s_barrier(); asm volatile("" ::: "memory");
#pragma unroll
        for (int ai = 0; ai < 2; ++ai)
#pragma unroll
            for (int m = 0; m < 4; ++m) { const int rl = wr * HALF + ai * 64 + m * 16 + fr; const float rs = red[rl];
                float* dst = yout + (size_t)(u.pm * BM + rl) * DM + col0;
#pragma unroll
                for (int bj = 0; bj < 2; ++bj) { EF_X(ai, m, bj, v0, v1)
                    *(f32x4*)(dst + bj * HALF) = v0 * rs * gv[bj][0]; *(f32x4*)(dst + bj * HALF + 4) = v1 * rs * gv[bj][1]; } }
#undef EF_X
    }
};
}

constexpr size_t MiB = 1u << 20;
constexpr size_t WS_CTL = 0, CTL_ZERO_BYTES = 1 * MiB;
constexpr size_t WS_ROPE = 1 * MiB;
constexpr size_t WS_WIN = 2 * MiB, WS_WOUT = 10 * MiB, WS_WUP = 14 * MiB, WS_WDN = 36 * MiB;
constexpr size_t WS_SSQA = 47 * MiB, WS_SSQB = 50 * MiB;
constexpr size_t WS_HEAD = 53 * MiB, WS_TAIL = 59 * MiB;
constexpr size_t WS_XB = 65 * MiB;
constexpr size_t WS_Z = 130 * MiB;
constexpr size_t WS_MIX = 260 * MiB;
constexpr size_t WS_ACT = 130 * MiB;
constexpr size_t WS_UPS = 488 * MiB;
constexpr size_t WS_END = 492 * MiB;
static_assert(WS_ACT + (size_t)MT * DFF * 2 <= WS_UPS && WS_UPS + (size_t)MS * NUP * 2 <= WS_END && WS_MIX + (size_t)MT * DM * 2 <= WS_END && WS_Z + (size_t)MT * NPROJ * 2 <= WS_MIX && WS_XB + (size_t)MT * DM * 2 <= WS_Z, "ws map");
static_assert(WS_HEAD + (size_t)128 * 2 * NUP * 4 <= WS_TAIL && WS_TAIL + (size_t)128 * 2 * NUP * 4 <= WS_XB && WS_SSQA + (size_t)16 * MT * 4 <= WS_SSQB && WS_SSQB + (size_t)16 * MT * 4 <= WS_TAIL, "ws map 2");
constexpr int CW_TMO = 0, CW_BAR = 4096, CW_PANEL = 16384;

constexpr int RING_BYTES = 131072;
constexpr int AUX_OFF = RING_BYTES;
constexpr int LDS_BYTES = 163840;
constexpr int MISC_OFF = LDS_BYTES - 128;

#define GAS __attribute__((address_space(1)))
#define LAS __attribute__((address_space(3)))
typedef unsigned short bf16;
typedef unsigned v4u __attribute__((ext_vector_type(4), may_alias));
typedef unsigned v2u __attribute__((ext_vector_type(2), may_alias));
typedef float f32x4 __attribute__((ext_vector_type(4)));
#define LDS_WAIT() asm volatile("s_waitcnt lgkmcnt(0)" ::: "memory")
__device__ __forceinline__ unsigned f2bf(float f) { unsigned u = __builtin_bit_cast(unsigned, f); return (u + 0x7fffu + ((u >> 16) & 1u)) >> 16; }
__device__ __forceinline__ unsigned pk2(float lo, float hi) { return f2bf(lo) | (f2bf(hi) << 16); }
__device__ __forceinline__ float bf2f(unsigned h) { return __builtin_bit_cast(float, h << 16); }
__device__ __forceinline__ float bflo(unsigned w) { return __builtin_bit_cast(float, w << 16); }
__device__ __forceinline__ float bfhi(unsigned w) { return __builtin_bit_cast(float, w & 0xffff0000u); }
__device__ __forceinline__ float gelu_t(float x) { const float y2 = 2.302208198f * (x + 0.044715f * x * x * x);     const float e = __builtin_amdgcn_exp2f(y2); return x * (1.f - __builtin_amdgcn_rcpf(e + 1.f)); }
__device__ __forceinline__ float silu_f(float x) { return x * __builtin_amdgcn_rcpf(1.f + __builtin_amdgcn_exp2f(-1.4426950408889634f * x)); }
__device__ __forceinline__ float wave_sum(float v) {
#pragma unroll
    for (int o = 1; o < 64; o <<= 1) v += __shfl_xor(v, o);
    return v;
}

#define XB_TMO      128
#define XB_XCNT(j)  (256  + 64 * (j))
#define XB_XSUB(j)  (1280 + 64 * (j))
#define XB_XGEN(j)  (2304 + 64 * (j))
#define XB_TOP      3328
#define XB_TOPGEN   3392
#define XCD_BAR_WORDS 3456
#define XB_SPIN_CAP (1u << 18)
__device__ __forceinline__ unsigned xb_ld(unsigned* p)              { return __hip_atomic_load(p, __ATOMIC_RELAXED, __HIP_MEMORY_SCOPE_AGENT); }
__device__ __forceinline__ unsigned xb_add(unsigned* p, unsigned v) { return __hip_atomic_fetch_add(p, v, __ATOMIC_RELAXED, __HIP_MEMORY_SCOPE_AGENT); }
__device__ __forceinline__ unsigned xb_xcc_id() { return (unsigned)__builtin_amdgcn_s_getreg((3 << 11) | 20) & 0xFu; }
#define XB_SPIN(cond, bar) do { unsigned _sp = 0; while (cond) { __builtin_amdgcn_s_sleep(1); \
    if ((++_sp & 255u) == 0u) { if (xb_ld(&(bar)[XB_TMO])) break; if (_sp > XB_SPIN_CAP) { atomicAdd(&(bar)[XB_TMO], 1u); break; } } } } while (0)
struct XcdBarrier { unsigned* bar; unsigned x; volatile LAS unsigned* st; };
__device__ __forceinline__ XcdBarrier xcd_barrier_post(unsigned* bar, volatile LAS unsigned* st) {
    XcdBarrier b; b.bar = bar; b.x = xb_xcc_id(); b.st = st;
    if (threadIdx.x == 0) (void)xb_add(&bar[XB_XCNT(b.x)], 1u);
    return b;
}
__device__ __forceinline__ void xcd_barrier_complete(unsigned* bar, unsigned x, unsigned& nloc, unsigned& nx) {
    const unsigned G = gridDim.x * gridDim.y * gridDim.z;
    unsigned sum, cnt, mine, sp = 0u;
    for (;;) {
        sum = 0u; cnt = 0u; mine = 0u;
#pragma unroll
        for (unsigned j = 0; j < 16; ++j) { const unsigned c = xb_ld(&bar[XB_XCNT(j)]); sum += c; cnt += (c > 0u) ? 1u : 0u; mine = (j == x) ? c : mine; }
        if (sum == G) break;
        __builtin_amdgcn_s_sleep(1);
        if ((++sp & 255u) == 0u) { if (xb_ld(&bar[XB_TMO])) break; if (sp > XB_SPIN_CAP) { atomicAdd(&bar[XB_TMO], 1u); break; } }
    }
    nloc = mine > 0u ? mine : 1u; nx = cnt > 0u ? cnt : 1u;
}
__device__ __forceinline__ void xcd_barrier(const XcdBarrier& b, int wave) {
    asm volatile("s_waitcnt vmcnt(0)" ::: "memory");
    __syncthreads();
    if (wave == 0 && lane_id() == 0) {
        unsigned* bar = b.bar;
        __builtin_amdgcn_s_waitcnt(0);
        unsigned nloc = b.st[0], nx = b.st[1];
        if (nloc == 0u) { xcd_barrier_complete(bar, b.x, nloc, nx); b.st[0] = nloc; b.st[1] = nx; }
        const unsigned old = xb_add(&bar[XB_XSUB(b.x)], 1u);
        const unsigned gen = old / nloc;
        if (old + 1u == (gen + 1u) * nloc) {
            __builtin_amdgcn_fence(__ATOMIC_RELEASE, "agent");
            asm volatile("s_waitcnt vmcnt(0)" ::: "memory");
            const unsigned og = xb_add(&bar[XB_TOP], 1u);
            const unsigned tg = og / nx;
            if (og + 1u == (tg + 1u) * nx) xb_add(&bar[XB_TOPGEN], 1u);
            else XB_SPIN(xb_ld(&bar[XB_TOPGEN]) == tg, bar);
            __builtin_amdgcn_fence(__ATOMIC_ACQUIRE, "agent");
            xb_add(&bar[XB_XGEN(b.x)], 1u);
            asm volatile("s_waitcnt vmcnt(0)" ::: "memory");
        } else {
            XB_SPIN(xb_ld(&bar[XB_XGEN(b.x)]) == gen, bar);
            __builtin_amdgcn_fence(__ATOMIC_ACQUIRE, "agent");
            asm volatile("s_waitcnt vmcnt(0)" ::: "memory");
        }
    }
    __syncthreads();
}

struct Args { const float* in[23]; float* out; unsigned char* ws; };
enum { I_XP = 0, I_XS, I_CK, I_CV, I_SCONV, I_SPOOL, I_SFFN, I_GMIX, I_WIN, I_SINK, I_CONVW, I_LNG, I_LNB, I_GW, I_GB, I_PW, I_PSC, I_WOUT, I_GFFN, I_WUP, I_FCW, I_WDN, I_GFIN };

#define CAS __attribute__((address_space(4)))
__device__ __forceinline__ const CAS char* karg_base() { const CAS char* kp = (const CAS char*)__builtin_amdgcn_kernarg_segment_ptr(); asm volatile("" : "+s"(kp)); return kp; }
#define AIN(i) (*(const float* const CAS*)(karg_base() + 8 * (i)))
#define AOUT() (*(float* const CAS*)(karg_base() + 184))
#define AWS() (*(unsigned char* const CAS*)(karg_base() + 192))
template <bool UPPERM> __device__ __forceinline__ void p0_transpose_item(const float* W, int K, int N, const float* g, bf16* WT, LAS float* scr, int item, int lane) {
    const int nblk = N / 32, kb = item / nblk, nb = item % nblk, k0 = 64 * kb, n0 = 32 * nb;
    const int d0 = UPPERM ? (n0 < DFF ? 256 * (n0 >> 7) + (n0 & 127) : 256 * ((n0 - DFF) >> 7) + 128 + ((n0 - DFF) & 127)) : n0;
    f32x4 ld[8]; float scv[8];
#pragma unroll
    for (int i = 0; i < 8; ++i) { const int kk = 8 * i + (lane >> 3); ld[i] = *(const f32x4*)(W + (size_t)(k0 + kk) * N + n0 + 4 * (lane & 7)); scv[i] = g ? g[k0 + kk] : 1.f; }
#pragma unroll
    for (int i = 0; i < 8; ++i) { const int kk = 8 * i + (lane >> 3); LAS float* d = scr + kk * 33 + 4 * (lane & 7);
        d[0] = ld[i][0] * scv[i]; d[1] = ld[i][1] * scv[i]; d[2] = ld[i][2] * scv[i]; d[3] = ld[i][3] * scv[i]; }
    LDS_WAIT(); asm volatile("" ::: "memory");
    const int c = lane & 7;
#pragma unroll
    for (int j = 0; j < 4; ++j) { const int n = (lane >> 3) + 8 * j; const LAS float* s = scr + (8 * c) * 33 + n;
        v4u o; o.x = pk2(s[0 * 33], s[1 * 33]); o.y = pk2(s[2 * 33], s[3 * 33]); o.z = pk2(s[4 * 33], s[5 * 33]); o.w = pk2(s[6 * 33], s[7 * 33]);
        *(GAS v4u*)(WT + (size_t)(d0 + n) * K + k0 + 8 * c) = o; }
    LDS_WAIT(); asm volatile("" ::: "memory");
}
__device__ __forceinline__ void sincos_d(double x, double& s, double& c) {
    const double n = __builtin_rint(x * 0.15915494309189535);
    double r = __builtin_fma(-n, 6.283185307179586, x); r = __builtin_fma(-n, 2.4492935982947064e-16, r);
    const double r2 = r * r; double ts = r, tc = 1.0; s = r; c = 1.0;
#pragma unroll
    for (int k = 1; k <= 14; ++k) { tc = -tc * r2 / (double)((2 * k - 1) * (2 * k)); c += tc; ts = -ts * r2 / (double)((2 * k) * (2 * k + 1)); s += ts; }
}

typedef float f32x16 __attribute__((ext_vector_type(16)));
typedef short bf16x8v __attribute__((ext_vector_type(8), may_alias));
typedef short s16x4 __attribute__((ext_vector_type(4), may_alias));
struct Seg { int smp, b, cu, nrows, row0, pos0; };
__device__ __forceinline__ Seg seg_prompt(int u) { Seg s; s.smp = 0; s.b = u >> 4; s.cu = u & 15; s.nrows = 128; s.row0 = s.b * SEQ + s.cu * 128; s.pos0 = s.cu * 128; return s; }
__device__ __forceinline__ Seg seg_sample(int b) { Seg s; s.smp = 1; s.b = b; s.cu = 0; s.nrows = ST; s.row0 = MP + b * ST; s.pos0 = SEQ; return s; }
struct MixCtx { const bf16* z; bf16* mix; float* out; int l; const float* rope; const bf16* gwb; const bf16* wpT; };
__device__ __forceinline__ int offK(int key, int ch) { return key * 128 + ((ch ^ ((key >> 1) & 7)) << 4); }
__device__ __forceinline__ int offV(int key, int ch) { return key * 128 + ((ch ^ (((key >> 1) & 1) << 2)) << 4); }
__device__ __forceinline__ s16x4 lds_tr(const LAS unsigned char* p) { return __builtin_bit_cast(s16x4, __builtin_amdgcn_ds_read_tr16_b64_v4i16((LAS s16x4*)p)); }
__device__ __forceinline__ unsigned cvtpk(float lo, float hi) { unsigned r; asm volatile("v_cvt_pk_bf16_f32 %0, %1, %2" : "=v"(r) : "v"(lo), "v"(hi)); return r; }
__device__ __forceinline__ v4u pack8(const f32x4 a, const f32x4 c) { v4u w; w.x = cvtpk(a[0], a[1]); w.y = cvtpk(a[2], a[3]); w.z = cvtpk(c[0], c[1]); w.w = cvtpk(c[2], c[3]); return w; }
__device__ __forceinline__ void st8f(float* o, v4u val) { *(f32x4*)o = (f32x4){bflo(val.x), bfhi(val.x), bflo(val.y), bfhi(val.y)}; *(f32x4*)(o + 4) = (f32x4){bflo(val.z), bfhi(val.z), bflo(val.w), bfhi(val.w)}; }

__device__ __forceinline__ void attn_unit(const MixCtx& C, const Seg& sg, const float* sinkp, const float* ck, const float* cv, LAS unsigned char* L, int wave) {
    const int lane = lane_id(), tid = wave * 64 + lane, l = C.l, b = sg.b, cu = sg.cu;
    const bf16* z = C.z; float* out = C.out;
    if (sg.smp) {
        for (int it = tid; it < ST * 48; it += 512) { const int t = it / 48, pr = it % 48, c1 = (pr >> 3) * 64 + (pr & 7);
            bf16* zr = (bf16*)z + (size_t)(sg.row0 + t) * NPROJ; const float x1 = bf2f(zr[c1]), x2 = bf2f(zr[c1 + 8]);
            const float cs = C.rope[(size_t)((SEQ + t) * 8 + (pr & 7)) * 2], sn = C.rope[(size_t)((SEQ + t) * 8 + (pr & 7)) * 2 + 1];
            zr[c1] = (bf16)f2bf(x1 * cs - x2 * sn); zr[c1 + 8] = (bf16)f2bf(x2 * cs + x1 * sn); }
        asm volatile("s_waitcnt vmcnt(0)" ::: "memory"); __syncthreads();
    }
    const int nk = sg.smp ? (WIN + ST) : 256;
    for (int it = tid; it < nk * 32; it += 512) {
        const int c32 = it & 31, kk = it >> 5, kv = c32 >> 4, hk = (c32 >> 3) & 1, ch = c32 & 7;
        v4u val;
        if (sg.smp && kk < WIN) { const float* src = (kv == 0 ? ck : cv) + (size_t)((b * 2 + l) * WIN + kk) * 128 + hk * 64 + 8 * ch; val = pack8(*(const f32x4*)src, *(const f32x4*)(src + 4)); }
        else { if (!sg.smp && cu == 0 && kk < 128) continue;
            const int row = sg.smp ? sg.row0 + (kk - WIN) : sg.row0 - 128 + kk; val = *(const v4u*)(z + (size_t)row * NPROJ + ZK + c32 * 8); }
        const int off = kv == 0 ? hk * 32768 + offK(kk, ch) : 65536 + hk * 32768 + offV(kk, ch);
        *(LAS v4u*)(L + off) = val;
        if (sg.smp) { if (kk >= WIN) st8f(out + (kv == 0 ? O_SK : O_SV) + (size_t)((b * 2 + l) * ST + (kk - WIN)) * 128 + hk * 64 + ch * 8, val); }
        else if (cu == 15 && kk >= 128) st8f(out + (kv == 0 ? O_PK : O_PV) + (size_t)((b * 2 + l) * WIN + (kk - 128)) * 128 + hk * 64 + ch * 8, val);
    }
    const int hq = sg.smp ? (wave & 3) : ((wave >> 2) * 2 + ((wave >> 1) & 1)), hk = hq >> 1, half = wave & 1, h = lane >> 5, r32 = lane & 31;
    const int ntask = sg.smp ? (wave < 4 ? 1 : 0) : 2;
    bf16x8v qfa[2][4];
#pragma unroll
    for (int qc = 0; qc < 2; ++qc) if (qc < ntask) { const int qrow = sg.smp ? sg.row0 + r32 : sg.row0 + qc * 64 + half * 32 + r32;
#pragma unroll
        for (int s = 0; s < 4; ++s) qfa[qc][s] = *(const bf16x8v*)(z + (size_t)qrow * NPROJ + ZQ + hq * 64 + 16 * s + 8 * h); }
    __syncthreads();
    const float sk = sinkp[l * 4 + hq];
    const LAS unsigned char* Kimg = L + hk * 32768; const LAS unsigned char* Vimg = L + 65536 + hk * 32768;
    constexpr float C1 = 0.125f * 1.4426950408889634f, LOG2E = 1.4426950408889634f;
#pragma unroll
    for (int qc = 0; qc < 2; ++qc) { if (qc < ntask) {
        const int qrow = sg.smp ? sg.row0 + r32 : sg.row0 + qc * 64 + half * 32 + r32, keybase = sg.smp ? 0 : qc * 64;
        const int Tstart = (!sg.smp && cu == 0) ? (qc == 0 ? 4 : 2) : 0, Tend = sg.smp ? 5 : 6;
        bf16x8v qf[4];
#pragma unroll
        for (int s = 0; s < 4; ++s) qf[s] = qfa[qc][s];
        f32x16 S[6]; float mx = -3.0e38f;
#pragma unroll
        for (int T = 0; T < 6; ++T) {
            if (T >= Tstart && T < Tend) {
                f32x16 a = {0.f, 0.f, 0.f, 0.f, 0.f, 0.f, 0.f, 0.f, 0.f, 0.f, 0.f, 0.f, 0.f, 0.f, 0.f, 0.f};
                const int key = keybase + 32 * T + r32;
#pragma unroll
                for (int s = 0; s < 4; ++s) { const bf16x8v kf = *(const LAS bf16x8v*)(Kimg + offK(key, 2 * s + h)); a = __builtin_amdgcn_mfma_f32_32x32x16_bf16(kf, qf[s], a, 0, 0, 0); }
                S[T] = a;
#pragma unroll
                for (int r = 0; r < 16; ++r) mx = fmaxf(mx, a[r]);
            } else {
#pragma unroll
                for (int r = 0; r < 16; ++r) S[T][r] = -3.0e38f;
            }
        }
        mx = fmaxf(mx, __shfl_xor(mx, 32));
        const float m = fmaxf(mx * 0.125f, sk), mb = m * LOG2E;
        float sum = 0.f;
#pragma unroll
        for (int T = 0; T < 6; ++T)
#pragma unroll
            for (int r = 0; r < 16; ++r) { const float p = __builtin_amdgcn_exp2f(S[T][r] * C1 - mb); S[T][r] = p; sum += p; }
        sum += __shfl_xor(sum, 32);
        const float inv = __builtin_amdgcn_rcpf(sum + __builtin_amdgcn_exp2f((sk - m) * LOG2E));
        f32x16 O[2];
#pragma unroll
        for (int dt = 0; dt < 2; ++dt)
#pragma unroll
            for (int r = 0; r < 16; ++r) O[dt][r] = 0.f;
        const int q4 = (lane & 15) >> 2, p4 = lane & 3, g2 = (lane >> 4) & 1;
#pragma unroll
        for (int T = 0; T < 6; ++T) {
            if (T >= Tstart && T < Tend) {
#pragma unroll
                for (int s = 0; s < 2; ++s) {
                    v4u pw; pw.x = cvtpk(S[T][8 * s + 0], S[T][8 * s + 1]); pw.y = cvtpk(S[T][8 * s + 2], S[T][8 * s + 3]); pw.z = cvtpk(S[T][8 * s + 4], S[T][8 * s + 5]); pw.w = cvtpk(S[T][8 * s + 6], S[T][8 * s + 7]);
                    const bf16x8v pf = __builtin_bit_cast(bf16x8v, pw);
                    const int k0 = keybase + 32 * T + 16 * s + 4 * h + q4;
#pragma unroll
                    for (int dt = 0; dt < 2; ++dt) {
                        const int chn = 2 * g2 + (p4 >> 1) + 4 * dt;
                        const s16x4 lo = lds_tr(Vimg + offV(k0, chn) + 8 * (p4 & 1)), hi = lds_tr(Vimg + offV(k0 + 8, chn) + 8 * (p4 & 1));
                        const bf16x8v vf = (bf16x8v){lo[0], lo[1], lo[2], lo[3], hi[0], hi[1], hi[2], hi[3]};
                        O[dt] = __builtin_amdgcn_mfma_f32_32x32x16_bf16(vf, pf, O[dt], 0, 0, 0);
                    }
                }
            }
        }
        bf16* op = C.mix + (size_t)qrow * DM + hq * 64 + 4 * h;
#pragma unroll
        for (int dt = 0; dt < 2; ++dt)
#pragma unroll
            for (int rg = 0; rg < 4; ++rg) { v2u w; w.x = cvtpk(O[dt][4 * rg] * inv, O[dt][4 * rg + 1] * inv); w.y = cvtpk(O[dt][4 * rg + 2] * inv, O[dt][4 * rg + 3] * inv);
                *(v2u*)(op + 32 * dt + 8 * rg) = w; }
    } }
    __syncthreads();
}
__device__ __forceinline__ int offGv(int j, int byte) { return 512 * j + ((((byte >> 6) ^ (j & 3))) << 6) + (byte & 63); }
__device__ __forceinline__ void gmlp_unit(const MixCtx& C, const Seg& sg, const float* lng, const float* lnb, const float* gb, LAS unsigned char* L, int wave) {
    const int lane = lane_id(), l = C.l, r0 = sg.row0, nrows = sg.nrows;
    const bf16* z = C.z;
    {
        const f32x4 gg = *(const f32x4*)(lng + l * 256 + 4 * lane), bb = *(const f32x4*)(lnb + l * 256 + 4 * lane);
        v2u raws[16];
#pragma unroll
        for (int jj = 0; jj < 16; ++jj) { const int j = wave + 8 * jj; if (j < nrows) raws[jj] = *(const v2u*)(z + (size_t)(r0 + j) * NPROJ + ZGV + 4 * lane); else raws[jj] = (v2u){0u, 0u}; }
        float xv[16][4], s1[16], s2[16];
#pragma unroll
        for (int jj = 0; jj < 16; ++jj) { const v2u raw = raws[jj];
            xv[jj][0] = gelu_t(bflo(raw.x)); xv[jj][1] = gelu_t(bfhi(raw.x)); xv[jj][2] = gelu_t(bflo(raw.y)); xv[jj][3] = gelu_t(bfhi(raw.y));
            s1[jj] = (xv[jj][0] + xv[jj][1]) + (xv[jj][2] + xv[jj][3]);
            s2[jj] = (xv[jj][0] * xv[jj][0] + xv[jj][1] * xv[jj][1]) + (xv[jj][2] * xv[jj][2] + xv[jj][3] * xv[jj][3]); }
#pragma unroll
        for (int o = 1; o < 64; o <<= 1) {
#pragma unroll
            for (int jj = 0; jj < 16; ++jj) { s1[jj] += __shfl_xor(s1[jj], o); s2[jj] += __shfl_xor(s2[jj], o); } }
#pragma unroll
        for (int jj = 0; jj < 16; ++jj) { const int j = wave + 8 * jj; if (j < nrows) {
            const float mean = s1[jj] * (1.f / 256.f), var = s2[jj] * (1.f / 256.f) - mean * mean;
            const float rstd = __builtin_amdgcn_rsqf(var + EPS);
            const f32x4 y = (f32x4){(xv[jj][0] - mean) * rstd * gg[0] + bb[0], (xv[jj][1] - mean) * rstd * gg[1] + bb[1], (xv[jj][2] - mean) * rstd * gg[2] + bb[2], (xv[jj][3] - mean) * rstd * gg[3] + bb[3]};
            v2u w; w.x = cvtpk(y[0], y[1]); w.y = cvtpk(y[2], y[3]);
            *(LAS v2u*)(L + offGv(j, 8 * lane)) = w;
            if (sg.smp) *(f32x4*)(C.out + O_SG + (size_t)((sg.b * 2 + l) * ST + j) * 256 + 4 * lane) = y;
        } }
    }
    __syncthreads();
    const int g = wave >> 1, dt = wave & 1, h = lane >> 5, r32 = lane & 31, q4 = (lane & 15) >> 2, p4 = lane & 3, g2 = (lane >> 4) & 1;
    const int nks = nrows >> 4, nit = nrows >> 5;
    f32x16 acc[4];
#pragma unroll
    for (int it = 0; it < 4; ++it)
#pragma unroll
        for (int r = 0; r < 16; ++r) acc[it][r] = 0.f;
    const bf16* wg = C.gwb + (size_t)((l * 4 + g) * 128) * 128;
    const int cb = 2 * (64 * g + 32 * dt + 16 * g2 + 4 * p4);
#pragma unroll
    for (int ks = 0; ks < 8; ++ks) {
        if (ks < nks) {
            const int j0 = 16 * ks + 8 * h;
            const s16x4 lo = lds_tr(L + offGv(j0 + q4, cb)), hi = lds_tr(L + offGv(j0 + 4 + q4, cb));
            const bf16x8v af = (bf16x8v){lo[0], lo[1], lo[2], lo[3], hi[0], hi[1], hi[2], hi[3]};
#pragma unroll
            for (int it = 0; it < 4; ++it) { if ((it < 2 && ks >= 4) || it >= nit) continue;
                const bf16x8v bf = *(const bf16x8v*)(wg + (size_t)(32 * it + r32) * 128 + 16 * ks + 8 * h);
                acc[it] = __builtin_amdgcn_mfma_f32_32x32x16_bf16(af, bf, acc[it], 0, 0, 0); }
        }
    }
    v2u uraw[4][4]; float bsv[4];
#pragma unroll
    for (int it = 0; it < 4; ++it) if (it < nit) { const int i = 32 * it + r32; bsv[it] = gb[(l * 4 + g) * 128 + i];
        const bf16* up = z + (size_t)(r0 + i) * NPROJ + ZGU + 64 * g + 32 * dt + 4 * h;
#pragma unroll
        for (int rg = 0; rg < 4; ++rg) uraw[it][rg] = *(const v2u*)(up + 8 * rg); }
#pragma unroll
    for (int it = 0; it < 4; ++it) {
        if (it < nit) {
            const int i = 32 * it + r32; const float bs = bsv[it];
            bf16* op = C.mix + (size_t)(r0 + i) * DM + 512 + 64 * g + 32 * dt + 4 * h;
#pragma unroll
            for (int rg = 0; rg < 4; ++rg) { const v2u ur = uraw[it][rg];
                v2u w; w.x = cvtpk(gelu_t(bflo(ur.x)) * (acc[it][4 * rg] + bs), gelu_t(bfhi(ur.x)) * (acc[it][4 * rg + 1] + bs)); w.y = cvtpk(gelu_t(bflo(ur.y)) * (acc[it][4 * rg + 2] + bs), gelu_t(bfhi(ur.y)) * (acc[it][4 * rg + 3] + bs));
                *(v2u*)(op + 8 * rg) = w; }
        }
    }
    __syncthreads();
}
__device__ __forceinline__ int offPl(int t, int ch) { return 512 * t + ((((ch >> 3) ^ (t & 15))) << 4) + 2 * (ch & 7); }
__device__ __forceinline__ void pool_unit(const MixCtx& C, const Seg& sg, const float* spool, const float* psc, LAS unsigned char* L, int wave) {
    const int lane = lane_id(), tid = wave * 64 + lane, l = C.l, r0 = sg.row0, nrows = sg.nrows;
    const bf16* z = C.z;
    LAS unsigned char* Pim = L; LAS unsigned char* Qim = L + 73728;
    const bool st_out = sg.smp || sg.cu == 15;
    for (int it = tid; it < (nrows + 15) * 32; it += 512) {
        const int e = it >> 5, c = it & 31; v4u val = (v4u){0u, 0u, 0u, 0u};
        if (e >= 15 || (!sg.smp && sg.cu > 0)) val = *(const v4u*)(z + (size_t)(r0 - 15 + e) * NPROJ + ZPI + 8 * c);
        else if (sg.smp) { const float* src = spool + (size_t)((sg.b * 2 + l) * 15 + e) * 256 + 8 * c; val = pack8(*(const f32x4*)src, *(const f32x4*)(src + 4)); }
        *(LAS v4u*)(Pim + e * 512 + c * 16) = val;
        if (st_out && e >= nrows) st8f(C.out + (sg.smp ? O_SP : O_PP) + (size_t)((sg.b * 2 + l) * 15 + (e - nrows)) * 256 + 8 * c, val);
    }
    __syncthreads();
    {
        const int ch = tid & 255, t0 = (tid >> 8) * 64, gq = ch >> 6, win = 2 << gq;
        if (t0 < nrows) {
            const int tend = (t0 + 64) < nrows ? (t0 + 64) : nrows;
            const LAS bf16* P = (const LAS bf16*)Pim;
            float sum = 0.f;
            for (int j = 1; j < win; ++j) sum += bf2f(P[(15 + t0 - j) * 256 + ch]);
            for (int t = t0; t < tend; t += 8) {
                float xs[8], xo[8];
#pragma unroll
                for (int i = 0; i < 8; ++i) { xs[i] = bf2f(P[(15 + t + i) * 256 + ch]); xo[i] = bf2f(P[(15 + t + i - (win - 1)) * 256 + ch]); }
#pragma unroll
                for (int i = 0; i < 8; ++i) { sum += xs[i];
                    const int pos = sg.pos0 + t + i; const int cnt = (pos + 1) < win ? (pos + 1) : win;
                    *(LAS bf16*)(Qim + offPl(t + i, ch)) = (bf16)f2bf(sum * __builtin_amdgcn_rcpf((float)cnt) - xs[i]);
                    sum -= xo[i]; }
            }
        }
    }
    __syncthreads();
    const int g = wave >> 1, dt = wave & 1, h = lane >> 5, r32 = lane & 31;
    bf16x8v af[4];
#pragma unroll
    for (int ks = 0; ks < 4; ++ks) af[ks] = *(const bf16x8v*)(C.wpT + (size_t)((l * 4 + g) * 64 + 32 * dt + r32) * 64 + 16 * ks + 8 * h);
    for (int tt = 0; tt < (nrows >> 5); ++tt) {
        f32x16 a = {0.f, 0.f, 0.f, 0.f, 0.f, 0.f, 0.f, 0.f, 0.f, 0.f, 0.f, 0.f, 0.f, 0.f, 0.f, 0.f};
        const int t = 32 * tt + r32;
#pragma unroll
        for (int ks = 0; ks < 4; ++ks) { const bf16x8v bf = *(const LAS bf16x8v*)(Qim + 512 * t + (((8 * g + 2 * ks + h) ^ (t & 15)) << 4)); a = __builtin_amdgcn_mfma_f32_32x32x16_bf16(af[ks], bf, a, 0, 0, 0); }
        bf16* op = C.mix + (size_t)(r0 + t) * DM + 768 + 64 * g + 32 * dt + 4 * h; const float* sc = psc + l * 256 + 64 * g + 32 * dt + 4 * h;
#pragma unroll
        for (int rg = 0; rg < 4; ++rg) { const f32x4 s4 = *(const f32x4*)(sc + 8 * rg);
            v2u w; w.x = cvtpk(a[4 * rg] * s4[0], a[4 * rg + 1] * s4[1]); w.y = cvtpk(a[4 * rg + 2] * s4[2], a[4 * rg + 3] * s4[3]); *(v2u*)(op + 8 * rg) = w; }
    }
    __syncthreads();
}
__device__ __forceinline__ void conv_unit(const MixCtx& C, const Seg& sg, const float* convw, const float* sconv, int wave) {
    const int lane = lane_id(), tid = wave * 64 + lane, l = C.l;
    const int r0 = sg.row0, cg = tid & 31, t0 = (tid >> 5) * 8, ch = 8 * cg;
    if (t0 >= sg.nrows) return;
    const bf16* z = C.z;
    float w[3][8];
#pragma unroll
    for (int j = 0; j < 3; ++j) { const f32x4 a = *(const f32x4*)(convw + (l * 3 + j) * 256 + ch), c = *(const f32x4*)(convw + (l * 3 + j) * 256 + ch + 4);
        w[j][0] = a[0]; w[j][1] = a[1]; w[j][2] = a[2]; w[j][3] = a[3]; w[j][4] = c[0]; w[j][5] = c[1]; w[j][6] = c[2]; w[j][7] = c[3]; }
    float m1[8], m2[8];
#pragma unroll
    for (int e = 0; e < 8; ++e) { m1[e] = 0.f; m2[e] = 0.f; }
    const bool st_out = sg.smp || sg.cu == 15;
#pragma unroll
    for (int i = -2; i < 8; ++i) {
        const int t = t0 + i; float m0[8];
        if (t >= 0 || (!sg.smp && sg.cu > 0)) { const bf16* zr = z + (size_t)(r0 + t) * NPROJ; const v4u a = *(const v4u*)(zr + ZCC + ch), c = *(const v4u*)(zr + ZCH + ch);
            m0[0] = bflo(a.x) * bflo(c.x); m0[1] = bfhi(a.x) * bfhi(c.x); m0[2] = bflo(a.y) * bflo(c.y); m0[3] = bfhi(a.y) * bfhi(c.y); m0[4] = bflo(a.z) * bflo(c.z); m0[5] = bfhi(a.z) * bfhi(c.z); m0[6] = bflo(a.w) * bflo(c.w); m0[7] = bfhi(a.w) * bfhi(c.w); }
        else if (sg.smp) { const float* sp = sconv + (size_t)((sg.b * 2 + l) * 2 + (t + 2)) * 256 + ch; const f32x4 a = *(const f32x4*)sp, c = *(const f32x4*)(sp + 4);
            m0[0] = a[0]; m0[1] = a[1]; m0[2] = a[2]; m0[3] = a[3]; m0[4] = c[0]; m0[5] = c[1]; m0[6] = c[2]; m0[7] = c[3]; }
        else {
#pragma unroll
            for (int e = 0; e < 8; ++e) m0[e] = 0.f; }
        if (i >= 0) {
            const v4u cbv = *(const v4u*)(z + (size_t)(r0 + t) * NPROJ + ZCB + ch);
            const float cbf[8] = {bflo(cbv.x), bfhi(cbv.x), bflo(cbv.y), bfhi(cbv.y), bflo(cbv.z), bfhi(cbv.z), bflo(cbv.w), bfhi(cbv.w)};
            float o[8];
#pragma unroll
            for (int e = 0; e < 8; ++e) o[e] = cbf[e] * (w[0][e] * m2[e] + w[1][e] * m1[e] + w[2][e] * m0[e]);
            v4u wv; wv.x = cvtpk(o[0], o[1]); wv.y = cvtpk(o[2], o[3]); wv.z = cvtpk(o[4], o[5]); wv.w = cvtpk(o[6], o[7]);
            *(v4u*)(C.mix + (size_t)(r0 + t) * DM + 256 + ch) = wv;
            if (st_out && t >= sg.nrows - 2) { float* o2 = C.out + (sg.smp ? O_SC : O_PC) + (size_t)((sg.b * 2 + l) * 2 + (t - (sg.nrows - 2))) * 256 + ch;
                *(f32x4*)o2 = (f32x4){m0[0], m0[1], m0[2], m0[3]}; *(f32x4*)(o2 + 4) = (f32x4){m0[4], m0[5], m0[6], m0[7]}; }
        }
#pragma unroll
        for (int e = 0; e < 8; ++e) { m2[e] = m1[e]; m1[e] = m0[e]; }
    }
}

template <int NT, int NCH>
__device__ __forceinline__ void sg_accumulate(const bf16* A, int lda, const bf16* Bt, int K, int t0, int n0, int kc0, LAS unsigned char* Lw, int lane, f32x16 (&acc)[NT]) {
    constexpr int NR = NT * 32 + 32, NI = NR / 8;
    const int lr = lane >> 3, lc = lane & 7, h = lane >> 5, r32 = lane & 31;
#pragma unroll
    for (int t = 0; t < NT; ++t)
#pragma unroll
        for (int r = 0; r < 16; ++r) acc[t][r] = 0.f;
    const bf16* rowp[NI];
#pragma unroll
    for (int i = 0; i < NI; ++i) { const int r = 8 * i + lr; rowp[i] = (i < 4 ? Bt + (size_t)(n0 + r) * K : A + (size_t)(t0 + r - 32) * lda) + kc0 * 64 + 8 * lc; }
    v4u buf[2][NI];
#pragma unroll
    for (int i = 0; i < NI; ++i) buf[0][i] = *(const v4u*)rowp[i];
#pragma unroll
    for (int c = 0; c < NCH; ++c) {
        if (c + 1 < NCH) {
#pragma unroll
            for (int i = 0; i < NI; ++i) buf[(c + 1) & 1][i] = *(const v4u*)(rowp[i] + 64 * (c + 1)); }
#pragma unroll
        for (int i = 0; i < NI; ++i) *(LAS v4u*)(Lw + (8 * i + lr) * 144 + lc * 16) = buf[c & 1][i];
#pragma unroll
        for (int s4 = 0; s4 < 4; ++s4) { const bf16x8v bw = *(const LAS bf16x8v*)(Lw + r32 * 144 + 32 * s4 + 16 * h);
#pragma unroll
            for (int t = 0; t < NT; ++t) { const bf16x8v ba = *(const LAS bf16x8v*)(Lw + (32 + 32 * t + r32) * 144 + 32 * s4 + 16 * h); acc[t] = __builtin_amdgcn_mfma_f32_32x32x16_bf16(bw, ba, acc[t], 0, 0, 0); } }
    }
}
template <int NT, int NSUM>
__device__ __forceinline__ f32x4 sg_reduce(const f32x16 (&a)[NT], int wave, LAS unsigned char* L, int lane, int rt, int rg, int src0, bool valid) {
    __syncthreads();
#pragma unroll
    for (int t = 0; t < NT; ++t)
#pragma unroll
        for (int g4 = 0; g4 < 4; ++g4) *(LAS f32x4*)(L + (size_t)((((wave * NT + t) * 4 + g4) * 64 + lane) * 16)) = (f32x4){a[t][4 * g4], a[t][4 * g4 + 1], a[t][4 * g4 + 2], a[t][4 * g4 + 3]};
    __syncthreads();
    f32x4 s = (f32x4){0.f, 0.f, 0.f, 0.f};
    if (valid) {
#pragma unroll
        for (int w = 0; w < NSUM; ++w) s += *(const LAS f32x4*)(L + (size_t)(((((src0 + w) * NT + rt) * 4 + rg) * 64 + lane) * 16)); }
    return s;
}
constexpr int SG_STG = 14336;
constexpr int SG_AUX = 8 * SG_STG;

template <int NTT>
__device__ __forceinline__ void sres_epilogue(bool valid, f32x4 v, int t0, int n0, int cb, int rt, int rg, int lane, int tid, bf16* xbs, float* ssq_out, LAS float* red) {
    const int h = lane >> 5, r32 = lane & 31;
    if (valid) { const int token = t0 + 32 * rt + r32, chn = n0 + 8 * rg + 4 * h;
        const v2u r = *(const v2u*)(xbs + (size_t)token * DM + chn);
        v2u w; w.x = cvtpk(bflo(r.x) + v[0], bfhi(r.x) + v[1]); w.y = cvtpk(bflo(r.y) + v[2], bfhi(r.y) + v[3]); *(v2u*)(xbs + (size_t)token * DM + chn) = w;
        const float q0 = bflo(w.x), q1 = bfhi(w.x), q2 = bflo(w.y), q3 = bfhi(w.y);
        float sq = (q0 * q0 + q1 * q1) + (q2 * q2 + q3 * q3); sq += __shfl_xor(sq, 32);
        if (h == 0) red[(rt * 4 + rg) * 32 + r32] = sq; }
    __syncthreads();
    if (tid < 32 * NTT) { const int rt2 = tid >> 5, r = tid & 31; ssq_out[cb * 256 + t0 + tid] = (red[(rt2 * 4 + 0) * 32 + r] + red[(rt2 * 4 + 1) * 32 + r]) + (red[(rt2 * 4 + 2) * 32 + r] + red[(rt2 * 4 + 3) * 32 + r]); }
    __syncthreads();
}

__global__ void __launch_bounds__(512, 2) trunk_fwd(Args args) {
    extern __shared__ __attribute__((aligned(16))) unsigned char lds[];
    LAS unsigned char* L = (LAS unsigned char*)lds;
    volatile LAS unsigned* MISC = (volatile LAS unsigned*)(L + MISC_OFF);
    unsigned* ctl = (unsigned*)(AWS() + WS_CTL);
    const int wave = __builtin_amdgcn_readfirstlane(threadIdx.x >> 6);
    if (threadIdx.x < 32) MISC[threadIdx.x] = 0u;
    __syncthreads();
    XcdBarrier bar = xcd_barrier_post(ctl + CW_BAR, MISC + 8);
#define DERIVE() int bx = blockIdx.x, G = gridDim.x; asm volatile("" : "+s"(bx), "+s"(G)); const int lane = lane_id(), tid = wave * 64 + lane, gw = bx * 8 + wave, NGW = G * 8; (void)lane; (void)gw; (void)NGW; unsigned char* ws = AWS(); float* out = AOUT(); \
    float* rope = (float*)(ws + WS_ROPE); bf16* gwb = (bf16*)(ws + WS_ROPE + 262144); bf16* wpT = (bf16*)(ws + WS_ROPE + 524288); float* ssqSA = (float*)(ws + WS_ROPE + 655360); float* ssqSB = (float*)(ws + WS_ROPE + 720896); (void)gwb; (void)wpT; (void)ssqSA; (void)ssqSB; bf16* Win_t = (bf16*)(ws + WS_WIN); bf16* Wout_t = (bf16*)(ws + WS_WOUT); bf16* Wup_t = (bf16*)(ws + WS_WUP); bf16* Wdn_t = (bf16*)(ws + WS_WDN); \
    float* ssqA = (float*)(ws + WS_SSQA); float* ssqB = (float*)(ws + WS_SSQB); float* headf = (float*)(ws + WS_HEAD); float* tailf = (float*)(ws + WS_TAIL); bf16* xb = (bf16*)(ws + WS_XB); bf16* zb = (bf16*)(ws + WS_Z); \
    bf16* mixb = (bf16*)(ws + WS_MIX); bf16* actb = (bf16*)(ws + WS_ACT); bf16* upsb = (bf16*)(ws + WS_UPS); LAS float* aux = (LAS float*)(L + AUX_OFF); \
    (void)rope; (void)Win_t; (void)Wout_t; (void)Wup_t; (void)Wdn_t; (void)ssqA; (void)ssqB; (void)headf; (void)tailf; (void)xb; (void)zb; (void)mixb; (void)actb; (void)upsb; (void)aux; (void)out;
#define IN(k) true
#define SEAM(k) xcd_barrier(bar, wave)

    if (IN(0)) { DERIVE()
        LAS float* scr = (LAS float*)(L + wave * 16384);
        constexpr int I_IN = (DM / 64) * (NPROJ / 32), I_OUT = (DM / 64) * (DM / 32), I_UP = (DM / 64) * (NUP / 32), I_DN = (DFF / 64) * (DM / 32), I_L = I_IN + I_OUT + I_UP + I_DN;
        for (int it = gw; it < 2 * I_L; it += NGW) {
            const int l = it / I_L; int r = it % I_L;
            if (r < I_IN) { p0_transpose_item<false>(AIN(I_WIN) + (size_t)l * DM * NPROJ, DM, NPROJ, AIN(I_GMIX) + l * DM, Win_t + (size_t)l * NPROJ * DM, scr, r, lane); continue; } r -= I_IN;
            if (r < I_OUT) { p0_transpose_item<false>(AIN(I_WOUT) + (size_t)l * DM * DM, DM, DM, nullptr, Wout_t + (size_t)l * DM * DM, scr, r, lane); continue; } r -= I_OUT;
            if (r < I_UP) { p0_transpose_item<true>(AIN(I_WUP) + (size_t)l * DM * NUP, DM, NUP, AIN(I_GFFN) + l * DM, Wup_t + (size_t)l * NUP * DM, scr, r, lane); continue; } r -= I_UP;
            p0_transpose_item<false>(AIN(I_WDN) + (size_t)l * DFF * DM, DFF, DM, nullptr, Wdn_t + (size_t)l * DM * DFF, scr, r, lane);
        }
        for (int m0 = gw; m0 < MT; m0 += 4 * NGW) {
            f32x4 v[4][4];
#pragma unroll
            for (int r = 0; r < 4; ++r) { const int m = m0 + r * NGW; if (m < MT) { const float* xr = m < MP ? AIN(I_XP) + (size_t)m * DM : AIN(I_XS) + (size_t)(m - MP) * DM; const GAS f32x4* x4 = (const GAS f32x4*)xr + lane;
#pragma unroll
                for (int j = 0; j < 4; ++j) v[r][j] = x4[64 * j]; } }
#pragma unroll
            for (int r = 0; r < 4; ++r) { const int m = m0 + r * NGW; if (m < MT) { float s = 0.f;
                GAS unsigned long long* o8 = (GAS unsigned long long*)(xb + (size_t)m * DM) + lane;
#pragma unroll
                for (int j = 0; j < 4; ++j) { const unsigned w0 = pk2(v[r][j].x, v[r][j].y), w1 = pk2(v[r][j].z, v[r][j].w); o8[64 * j] = (unsigned long long)w0 | ((unsigned long long)w1 << 32);
                    s += (bflo(w0) * bflo(w0) + bfhi(w0) * bfhi(w0)) + (bflo(w1) * bflo(w1) + bfhi(w1) * bfhi(w1)); }
                s = wave_sum(s);
                if (m < MP) { if (lane < 4) ssqA[(size_t)lane * MT + m] = lane == 0 ? s : 0.f; } else if (lane == 0) ssqSA[m - MP] = s; } }
        }
        for (int i = bx * 512 + tid; i < (SEQ + ST) * 8; i += G * 512) {
            const int pos = i >> 3, f = i & 7;
            const double invf[8] = {1.0, 0.19392274474868576, 0.03760603093086393, 0.007292664737217109, 0.001414213562373095, 0.0002742481756762073, 5.318295896944988e-05, 1.031338537721246e-05};
            double fr = 1.0;
#pragma unroll
            for (int j = 0; j < 8; ++j) fr = (f == j) ? invf[j] : fr;
            const float ang = (float)pos * (float)fr; double s, c; sincos_d((double)ang, s, c);
            rope[2 * i] = (float)c; rope[2 * i + 1] = (float)s;
        }
        for (int i = bx * 512 + tid; i < 2 * 4 * 128 * 128; i += G * 512) { const int j = i & 127, ii = (i >> 7) & 127; gwb[i] = (bf16)((j >> 6) <= (ii >> 6) ? f2bf(AIN(I_GW)[i]) : 0u); }
        for (int i = bx * 512 + tid; i < 2 * 4 * 64 * 64; i += G * 512) { const int c = i & 63, d = (i >> 6) & 63, lg = i >> 12; wpT[i] = (bf16)f2bf(AIN(I_PW)[(size_t)(lg * 64 + c) * 64 + d]); }
        SEAM(0);
    }

    for (int l = 0; l < 2; ++l) {
        const int pb = 1 + 6 * l;
        if (IN(pb)) { DERIVE()
            pg8::Gemm g{xb, Win_t + (size_t)l * NPROJ * DM, MP, NPROJ, DM, DM}; pg8::StaticOrder S; S.init(MP, NPROJ, G, bx);
            pg8::EpiRow<1> E{{}, zb, NPROJ, ssqA, l == 0 ? 1 : 4, aux, rope, L + AUX_OFF + 16384};
            pg8::gemm_phase<pg8::EpiRow<1>, true, true>(L, g, S, E, wave);
            {
                LAS float* rsl = (LAS float*)(L + SG_AUX); const int np = l == 0 ? 1 : 32;
                for (int su = bx; su < 256; su += G) { const int t0 = (su & 3) * 64, n0 = (su >> 2) * 32;
                    if (tid < 64) { float sq = 0.f; for (int p = 0; p < np; ++p) sq += ssqSA[p * 256 + t0 + tid]; rsl[tid] = __builtin_amdgcn_rsqf(sq * (1.0f / DM) + EPS); }
                    f32x16 acc2[2]; sg_accumulate<2, 2>(xb + (size_t)MP * DM, DM, Win_t + (size_t)l * NPROJ * DM, DM, t0, n0, 2 * wave, L + wave * SG_STG, lane, acc2);
                    const int rt = wave >> 2, rg = wave & 3;
                    const f32x4 v = sg_reduce<2, 8>(acc2, wave, L, lane, rt, rg, 0, true);
                    const int tl = 32 * rt + (lane & 31); const float rs = rsl[tl];
                    v2u w; w.x = cvtpk(v[0] * rs, v[1] * rs); w.y = cvtpk(v[2] * rs, v[3] * rs);
                    *(v2u*)(zb + (size_t)(MP + t0 + tl) * NPROJ + n0 + 8 * rg + 4 * (lane >> 5)) = w;
                    __syncthreads(); }
            }
            SEAM(pb);
        }
        if (IN(pb + 1)) { DERIVE()
            MixCtx C{zb, mixb, out, l, rope, gwb, wpT};
            for (int u = bx; u < 256 + 4 * SB; u += G) {
                if (u < 256) { const Seg sg = seg_prompt(u);
                    attn_unit(C, sg, AIN(I_SINK), AIN(I_CK), AIN(I_CV), L, wave);
                    gmlp_unit(C, sg, AIN(I_LNG), AIN(I_LNB), AIN(I_GB), L, wave);
                    pool_unit(C, sg, AIN(I_SPOOL), AIN(I_PSC), L, wave);
                    conv_unit(C, sg, AIN(I_CONVW), AIN(I_SCONV), wave);
                } else { const Seg sg = seg_sample((u - 256) >> 2); const int kind = (u - 256) & 3;
                    if (kind == 0) conv_unit(C, sg, AIN(I_CONVW), AIN(I_SCONV), wave);
                    else if (kind == 1) attn_unit(C, sg, AIN(I_SINK), AIN(I_CK), AIN(I_CV), L, wave);
                    else if (kind == 2) gmlp_unit(C, sg, AIN(I_LNG), AIN(I_LNB), AIN(I_GB), L, wave);
                    else pool_unit(C, sg, AIN(I_SPOOL), AIN(I_PSC), L, wave);
                }
            }
            SEAM(pb + 1);
        }
        if (IN(pb + 2)) { DERIVE()
            pg8::Gemm g{mixb, Wout_t + (size_t)l * DM * DM, MP, DM, DM, DM}; pg8::StaticOrder S; S.init(MP, DM, G, bx);
            pg8::EpiRes E{{}, xb, xb, ssqB, aux};
            pg8::gemm_phase<pg8::EpiRes, true, true>(L, g, S, E, wave);
            {
                LAS float* red = (LAS float*)(L + SG_AUX);
                for (int su = bx; su < 256; su += G) { const int t0 = (su & 7) * 32, cb = su >> 3, n0 = cb * 32;
                    f32x16 acc1[1]; sg_accumulate<1, 2>(mixb + (size_t)MP * DM, DM, Wout_t + (size_t)l * DM * DM, DM, t0, n0, 2 * wave, L + wave * SG_STG, lane, acc1);
                    const bool valid = wave < 4; const f32x4 v = sg_reduce<1, 8>(acc1, wave, L, lane, 0, wave & 3, 0, valid);
                    sres_epilogue<1>(valid, v, t0, n0, cb, 0, wave & 3, lane, tid, xb + (size_t)MP * DM, ssqSB, red); }
            }
            SEAM(pb + 2);
        }
        if (IN(pb + 3)) { DERIVE()
            pg8::Gemm g{xb, Wup_t + (size_t)l * NUP * DM, MP, NUP, DM, DM}; pg8::StaticOrder S; S.init(MP, NUP, G, bx);
            pg8::EpiUpAct E{{}, actb, ssqB, 4, aux, (LAS f32x4*)(L + AUX_OFF + 8192), (LAS float*)(L + AUX_OFF + 10240), AIN(I_FCW) + (size_t)l * 3 * NUP, headf, tailf, out + O_PF + (size_t)l * 2 * NUP};
            pg8::gemm_phase<pg8::EpiUpAct, true, true, true>(L, g, S, E, wave);
            {
                LAS float* rsl = (LAS float*)(L + SG_AUX);
                for (int su = bx; su < 4 * (NUP / 32); su += G) { const int t0 = (su & 3) * 64, n0 = (su >> 2) * 32;
                    if (tid < 64) { float sq = 0.f; for (int p = 0; p < 32; ++p) sq += ssqSB[p * 256 + t0 + tid]; rsl[tid] = __builtin_amdgcn_rsqf(sq * (1.0f / DM) + EPS); }
                    f32x16 acc2[2]; sg_accumulate<2, 2>(xb + (size_t)MP * DM, DM, Wup_t + (size_t)l * NUP * DM, DM, t0, n0, 2 * wave, L + wave * SG_STG, lane, acc2);
                    const int rt = wave >> 2, rg = wave & 3;
                    const f32x4 v = sg_reduce<2, 8>(acc2, wave, L, lane, rt, rg, 0, true);
                    const int tl = 32 * rt + (lane & 31); const float rs = rsl[tl];
                    v2u w; w.x = cvtpk(v[0] * rs, v[1] * rs); w.y = cvtpk(v[2] * rs, v[3] * rs);
                    *(v2u*)(upsb + (size_t)(t0 + tl) * NUP + n0 + 8 * rg + 4 * (lane >> 5)) = w;
                    __syncthreads(); }
            }
            SEAM(pb + 3);
        }
        if (IN(5)) { DERIVE()
            constexpr int NCG = DFF / 8, NFIX = 112 * NCG, NSMP = MS * NCG;
            const float* fcw = AIN(I_FCW) + (size_t)l * 3 * NUP;
            for (int task = bx * 512 + tid; task < NFIX + NSMP; task += G * 512) {
                const bool smp = task >= NFIX; const int tk = smp ? task - NFIX : task; const int q = tk / NCG, ch = (tk % NCG) * 8;
                const int ic = 256 * (ch >> 7) + (ch & 127);
                float wg[3][8], wv[3][8];
#pragma unroll
                for (int j = 0; j < 3; ++j) { const f32x4 a0 = *(const f32x4*)(fcw + j * NUP + ch), a1 = *(const f32x4*)(fcw + j * NUP + ch + 4), c0 = *(const f32x4*)(fcw + j * NUP + DFF + ch), c1 = *(const f32x4*)(fcw + j * NUP + DFF + ch + 4);
#pragma unroll
                    for (int e = 0; e < 4; ++e) { wg[j][e] = a0[e]; wg[j][4 + e] = a1[e]; wv[j][e] = c0[e]; wv[j][4 + e] = c1[e]; } }
                if (!smp) {
                    float gh[2][8], vh[2][8];
                    const int pm = (q / 7) * 8 + (q % 7) + 1;
#pragma unroll
                    for (int j = 0; j < 2; ++j) { const float* tp = tailf + (size_t)((pm - 1) * 2 + j) * NUP + ic; const f32x4 a0 = *(const f32x4*)tp, a1 = *(const f32x4*)(tp + 4), c0 = *(const f32x4*)(tp + 128), c1 = *(const f32x4*)(tp + 132);
#pragma unroll
                        for (int e = 0; e < 4; ++e) { gh[j][e] = a0[e]; gh[j][4 + e] = a1[e]; vh[j][e] = c0[e]; vh[j][4 + e] = c1[e]; } }
#pragma unroll
                    for (int r = 0; r < 2; ++r) { const float* hp = headf + (size_t)(pm * 2 + r) * NUP + ic; const f32x4 a0 = *(const f32x4*)hp, a1 = *(const f32x4*)(hp + 4), c0 = *(const f32x4*)(hp + 128), c1 = *(const f32x4*)(hp + 132);
                        float gg[8] = {a0[0], a0[1], a0[2], a0[3], a1[0], a1[1], a1[2], a1[3]}, vv[8] = {c0[0], c0[1], c0[2], c0[3], c1[0], c1[1], c1[2], c1[3]}; float o[8];
#pragma unroll
                        for (int e = 0; e < 8; ++e) { const float Gc = wg[0][e] * gh[0][e] + wg[1][e] * gh[1][e] + wg[2][e] * gg[e]; const float Vc = wv[0][e] * vh[0][e] + wv[1][e] * vh[1][e] + wv[2][e] * vv[e];
                            o[e] = silu_f(Gc) * Vc; gh[0][e] = gh[1][e]; gh[1][e] = gg[e]; vh[0][e] = vh[1][e]; vh[1][e] = vv[e]; }
                        v4u w; w.x = pk2(o[0], o[1]); w.y = pk2(o[2], o[3]); w.z = pk2(o[4], o[5]); w.w = pk2(o[6], o[7]);
                        *(v4u*)(actb + (size_t)(pm * 256 + r) * DFF + ch) = w; }
                } else {
                    const int b = q >> 5, r = q & 31;
                    float xg[3][8], xv[3][8];
#pragma unroll
                    for (int j = 0; j < 3; ++j) { const int rr = r - 2 + j;
                        if (rr >= 0) { const bf16* rp = upsb + (size_t)(b * ST + rr) * NUP + ic; const v4u a = *(const v4u*)rp, c = *(const v4u*)(rp + 128);
                            xg[j][0] = bflo(a.x); xg[j][1] = bfhi(a.x); xg[j][2] = bflo(a.y); xg[j][3] = bfhi(a.y); xg[j][4] = bflo(a.z); xg[j][5] = bfhi(a.z); xg[j][6] = bflo(a.w); xg[j][7] = bfhi(a.w);
                            xv[j][0] = bflo(c.x); xv[j][1] = bfhi(c.x); xv[j][2] = bflo(c.y); xv[j][3] = bfhi(c.y); xv[j][4] = bflo(c.z); xv[j][5] = bfhi(c.z); xv[j][6] = bflo(c.w); xv[j][7] = bfhi(c.w); }
                        else { const float* st = AIN(I_SFFN) + (size_t)((b * 2 + l) * 2 + (rr + 2)) * NUP; const f32x4 a0 = *(const f32x4*)(st + ch), a1 = *(const f32x4*)(st + ch + 4), c0 = *(const f32x4*)(st + DFF + ch), c1 = *(const f32x4*)(st + DFF + ch + 4);
#pragma unroll
                            for (int e = 0; e < 4; ++e) { xg[j][e] = a0[e]; xg[j][4 + e] = a1[e]; xv[j][e] = c0[e]; xv[j][4 + e] = c1[e]; } } }
                    float o[8];
#pragma unroll
                    for (int e = 0; e < 8; ++e) { const float Gc = wg[0][e] * xg[0][e] + wg[1][e] * xg[1][e] + wg[2][e] * xg[2][e]; const float Vc = wv[0][e] * xv[0][e] + wv[1][e] * xv[1][e] + wv[2][e] * xv[2][e]; o[e] = silu_f(Gc) * Vc; }
                    v4u w; w.x = pk2(o[0], o[1]); w.y = pk2(o[2], o[3]); w.z = pk2(o[4], o[5]); w.w = pk2(o[6], o[7]);
                    *(v4u*)(actb + (size_t)(MP + b * ST + r) * DFF + ch) = w;
                    if (r >= ST - 2) { float* sp = out + O_SF + (size_t)((b * 2 + l) * 2 + (r - (ST - 2))) * NUP + ch;
                        *(f32x4*)sp = (f32x4){xg[2][0], xg[2][1], xg[2][2], xg[2][3]}; *(f32x4*)(sp + 4) = (f32x4){xg[2][4], xg[2][5], xg[2][6], xg[2][7]};
                        *(f32x4*)(sp + DFF) = (f32x4){xv[2][0], xv[2][1], xv[2][2], xv[2][3]}; *(f32x4*)(sp + DFF + 4) = (f32x4){xv[2][4], xv[2][5], xv[2][6], xv[2][7]}; }
                }
            }
            SEAM(pb + 4);
        }
        if (IN(pb + 5)) { DERIVE()
            pg8::Gemm g{actb, Wdn_t + (size_t)l * DM * DFF, MP, DM, DFF, DFF}; pg8::StaticOrder S; S.init(MP, DM, G, bx);
            if (l == 1 && G == 256) { pg8::EpiFinal Ef{{}, xb, out, AIN(I_GFIN), ssqB + (size_t)8 * MT, ctl + CW_PANEL, aux}; pg8::gemm_phase<pg8::EpiFinal, true, true>(L, g, S, Ef, wave); }
            else { pg8::EpiRes E{{}, xb, xb, ssqA, aux}; pg8::gemm_phase<pg8::EpiRes, true, true>(L, g, S, E, wave); }
            {
                LAS float* red = (LAS float*)(L + SG_AUX);
                for (int su = bx; su < 128; su += G) { const int t0 = (su & 3) * 64, cb = su >> 2, n0 = cb * 32;
                    f32x16 acc1[1]; sg_accumulate<1, 11>(actb + (size_t)MP * DFF, DFF, Wdn_t + (size_t)l * DM * DFF, DFF, t0 + 32 * (wave >> 2), n0, 11 * (wave & 3), L + wave * SG_STG, lane, acc1);
                    const f32x4 v = sg_reduce<1, 4>(acc1, wave, L, lane, 0, wave & 3, (wave >> 2) * 4, true);
                    sres_epilogue<2>(true, v, t0, n0, cb, wave >> 2, wave & 3, lane, tid, xb + (size_t)MP * DM, ssqSA, red); }
            }
            SEAM(pb + 5);
        }
    }
    if (IN(13)) { DERIVE()
        const float* gf = AIN(I_GFIN);
        for (int m = (G == 256 ? MP : 0) + gw; m < MT; m += NGW) {
            float s = 0.f; if (m < MP) { if (lane < 4) s = ssqA[(size_t)lane * MT + m]; } else if (lane < 32) s = ssqSA[lane * 256 + (m - MP)];
            s = wave_sum(s); const float rs = __builtin_amdgcn_rsqf(s * (1.0f / DM) + EPS);
            const GAS v2u* xin = (const GAS v2u*)(xb + (size_t)m * DM) + lane; GAS f32x4* y4 = (GAS f32x4*)(out + (size_t)m * DM) + lane; const f32x4* g4 = (const f32x4*)gf + lane;
#pragma unroll
            for (int j = 0; j < 4; ++j) { const v2u w = xin[64 * j]; const f32x4 gg = g4[64 * j]; y4[64 * j] = (f32x4){bflo(w.x) * rs * gg.x, bfhi(w.x) * rs * gg.y, bflo(w.y) * rs * gg.z, bfhi(w.y) * rs * gg.w}; }
        }
    }
#undef IN
#undef SEAM
}

extern "C" void kernel_launch(void* const* d_in, const int* in_sizes, int n_in, void* d_out, int out_size, void* d_ws, size_t ws_size, hipStream_t stream) {
    static int grid = 0;
    if (grid == 0) {
        if (n_in != 23 || in_sizes[0] != MP * DM || (size_t)out_size != O_END || ws_size < WS_END) { fprintf(stderr, "kernel_launch: unexpected shapes: n_in %d in0 %d out %d ws %zu\n", n_in, n_in > 0 ? in_sizes[0] : -1, out_size, ws_size); grid = -1; return; }
        int dev = 0, cus = 0;
        if (hipGetDevice(&dev) != hipSuccess || hipDeviceGetAttribute(&cus, hipDeviceAttributeMultiprocessorCount, dev) != hipSuccess) { grid = -1; return; }
        if (hipFuncSetAttribute((const void*)trunk_fwd, hipFuncAttributeMaxDynamicSharedMemorySize, LDS_BYTES) != hipSuccess) { fprintf(stderr, "kernel_launch: hipFuncSetAttribute failed\n"); grid = -1; return; }
        int per_cu = 0;
        if (hipOccupancyMaxActiveBlocksPerMultiprocessor(&per_cu, (const void*)trunk_fwd, 512, LDS_BYTES) != hipSuccess || per_cu < 1) fprintf(stderr, "kernel_launch: occupancy query reports %d\n", per_cu);
        (void)hipGetLastError();
        grid = cus;
    }
    if (grid < 0) return;
    (void)hipMemsetAsync((char*)d_ws + WS_CTL, 0, CTL_ZERO_BYTES, stream);
    Args a{};
    for (int i = 0; i < 23; ++i) a.in[i] = (const float*)d_in[i];
    a.out = (float*)d_out; a.ws = (unsigned char*)d_ws;
    hipLaunchKernelGGL(trunk_fwd, dim3(grid), dim3(512), LDS_BYTES, stream, a);
}
```

```cpp
#include <hip/hip_runtime.h>
#include <cstdio>
#include <cstdint>

constexpr int DM = 1024, NB = 16, SEQ = 2048, MP = NB * SEQ, SB = 8, ST = 32, MS = SB * ST, MT = MP + MS;
constexpr int NPROJ = 2048, DFF = 2816, NUP = 2 * DFF, WIN = 128;
constexpr size_t ZBLK = (size_t)MT * 256;
#define ZOFF(row, col) ((size_t)((col) >> 8) * ZBLK + (size_t)(row) * 256 + ((col) & 255))
constexpr float EPS = 1e-6f;
constexpr int ZQ = 0, ZK = 256, ZV = 384, ZCB = 512, ZCC = 768, ZCH = 1024, ZGU = 1280, ZGV = 1536, ZPI = 1792;
constexpr size_t O_YP = 0, O_YS = 33554432, O_PK = 33816576, O_PV = 34340864, O_PC = 34865152, O_PP = 34881536, O_PF = 35004416,
                 O_SK = 35364864, O_SV = 35430400, O_SC = 35495936, O_SP = 35504128, O_SF = 35565568, O_SG = 35745792, O_END = 35876864;

__device__ __forceinline__ int lane_id() { int l; asm volatile("v_mbcnt_lo_u32_b32 %0, -1, 0\n\tv_mbcnt_hi_u32_b32 %0, -1, %0" : "=v"(l)); return l; }
namespace pg8 {
#define PG8_LAS __attribute__((address_space(3)))
typedef unsigned short bf16_t;
typedef short bf16x8 __attribute__((ext_vector_type(8)));
typedef float f32x4 __attribute__((ext_vector_type(4)));
typedef unsigned u32x4 __attribute__((ext_vector_type(4)));
constexpr int BM = 256, BK = 64, HALF = 128, HTB = HALF * BK * 2, STAGE_BYTES = 8 * HTB, NXCD = 8, WGM = 8;

__host__ __device__ __forceinline__ int lds_byte(int r, int c) { const int st = (r >> 4) * 2 + (c >> 5), rr = r & 15, cc = c & 31, ob = rr * 64 + cc * 2; return st * 1024 + (ob ^ (((ob >> 9) & 1) << 5)); }
__host__ __device__ __forceinline__ void stage_rc(int b, int& R, int& C) { const int st = b / 1024, sb = b % 1024, swz = sb ^ (((sb >> 9) & 1) << 5); R = (st >> 1) * 16 + swz / 64; C = (st & 1) * 32 + (swz % 64) / 2; }
__host__ __device__ __forceinline__ int perm32(int rho) { const int n = rho >> 4, i = rho & 15; return 8 * (i >> 2) + 4 * n + (i & 3); }
__host__ __device__ __forceinline__ int perm32b(int rho) { const int n = rho >> 4, i = rho & 15, q = i >> 2; return 16 * (q >> 1) + 4 * (q & 1) + 8 * n + (i & 3); }

struct Unit { int pm, pn; };
struct Gemm { const bf16_t* A; const bf16_t* Bt; int M, N, K, lda; };

struct StaticOrder {
    int nM, nN, nwg, G, c;
    __host__ __device__ void init(int M, int N, int G_, int c_) { nM = M / BM; nN = N / BM; nwg = nM * nN; G = G_; c = c_; }
    __host__ __device__ bool next(int i, Unit& u) const {
        const long L = (long)i * G + c; if (L >= nwg) return false;
        int wgid = (int)L; { const int q = nwg / NXCD, r = nwg % NXCD, xcd = wgid % NXCD, off = wgid / NXCD; wgid = (xcd < r ? xcd * (q + 1) : r * (q + 1) + (xcd - r) * q) + off; }
        const int nig = WGM * nN, gid = wgid / nig, fm = gid * WGM, gsz = (nM - fm) < WGM ? (nM - fm) : WGM;
        u.pm = fm + ((wgid % nig) % gsz); u.pn = (wgid % nig) / gsz; return true;
    }
};

__device__ __forceinline__ unsigned cvt_pk_bf16(float lo, float hi) { unsigned r; asm volatile("v_cvt_pk_bf16_f32 %0, %1, %2" : "=v"(r) : "v"(lo), "v"(hi)); return r; }

template <class Epi, bool ALIGN_EPI, bool SP2, bool AROW8 = false>
__device__ __forceinline__ void gemm_phase(PG8_LAS unsigned char* lds, const Gemm g, const StaticOrder& S, const Epi& E, int wid_s) {
    const int lane = lane_id(); const int wid = wid_s, tid = wid * 64 + lane, wr = wid >> 2, wc = wid & 3, fr = lane & 15, fq = lane >> 4;
    const int K = g.K, nt = K / BK, lda = g.lda;
    unsigned voffA[2], voffB[2];
#pragma unroll
    for (int i = 0; i < 2; ++i) { int R, C; stage_rc(tid * 16 + i * 8192, R, C); const int Rb = (int)Epi::PERM == 2 ? ((R & ~31) + perm32b(R & 31)) : Epi::PERM ? ((R & ~31) + perm32(R & 31)) : R;
        voffA[i] = (unsigned)((AROW8 ? (128 * (R >> 6) + 8 * (R & 15) + ((R >> 4) & 3)) : (128 * (R >> 6) + (R & 63))) * lda + C) * 2u; voffB[i] = (unsigned)(Rb * K + C) * 2u; }
    const size_t kstep = (size_t)(BK * 2);
    const size_t hstepA = (size_t)(AROW8 ? 4 : 64) * lda * 2, hstepB = (size_t)HALF * K * 2;
    const size_t tstepA = (size_t)BM * lda * 2, tstepB = 2 * hstepB;
    const unsigned ldsw = (unsigned)wid * 1024u;
    const int aoff = lds_byte(wr * 64 + fr, fq * 8), boff = lds_byte(wc * 32 + fr, fq * 8);
#define PG8_SA(b, h) (((b) * 2 + (h)) * HTB)
#define PG8_SB(b, h) ((4 + (b) * 2 + (h)) * HTB)
#define PG8_STAGE(bufoff, gbase, voff) do { _Pragma("unroll") for (int _i = 0; _i < 2; ++_i) \
        __builtin_amdgcn_global_load_lds((const unsigned*)((const char*)(gbase) + (voff)[_i]), (PG8_LAS unsigned*)(lds + (bufoff) + ldsw + _i * 8192), 16, 0, 0); } while (0)
#define PG8_LDA(dst, b, h) do { _Pragma("unroll") for (int m = 0; m < 4; ++m) _Pragma("unroll") for (int k = 0; k < 2; ++k) dst[m][k] = *(const PG8_LAS bf16x8*)(lds + PG8_SA(b, h) + aoff + m * 2048 + k * 1024); } while (0)
#define PG8_LDB(dst, b, h) do { _Pragma("unroll") for (int n = 0; n < 2; ++n) _Pragma("unroll") for (int k = 0; k < 2; ++k) dst[n][k] = *(const PG8_LAS bf16x8*)(lds + PG8_SB(b, h) + boff + n * 2048 + k * 1024); } while (0)
#define PG8_MMA(ai, bj, At, Bt) do { __builtin_amdgcn_s_setprio(1); _Pragma("unroll") for (int m = 0; m < 4; ++m) _Pragma("unroll") for (int n = 0; n < 2; ++n) _Pragma("unroll") for (int k = 0; k < 2; ++k) \
        acc[ai][bj][m][n] = __builtin_amdgcn_mfma_f32_16x16x32_bf16(Bt[n][k], At[m][k], acc[ai][bj][m][n], 0, 0, 0); __builtin_amdgcn_s_setprio(0); } while (0)
#define PG8_WAIT_V(n) asm volatile("s_waitcnt vmcnt(" #n ")" ::: "memory")
#define PG8_WAIT_L(n) asm volatile("s_waitcnt lgkmcnt(" #n ")" ::: "memory")
#define PG8_BAR __builtin_amdgcn_s_barrier()
#define PG8_SCHED __builtin_amdgcn_sched_barrier(0)
    Unit cur, nxt; int ui = 0;
    if (!S.next(0, cur)) return;
    f32x4 acc[2][2][4][2];
    typename Epi::InitT ini; E.init_load(ini, cur, wr, wc);
    bf16x8 At[4][2], B0[2][2], B1[2][2];
    const char* cA = (const char*)g.A + (size_t)cur.pm * tstepA; const char* cB = (const char*)g.Bt + (size_t)cur.pn * tstepB;
    E.prep(cur, 0, wid, lane);
    if constexpr (SP2) {
        PG8_STAGE(PG8_SB(0, 0), cB, voffB); PG8_STAGE(PG8_SB(0, 1), cB + hstepB, voffB); PG8_STAGE(PG8_SA(0, 0), cA, voffA); PG8_STAGE(PG8_SA(0, 1), cA + hstepA, voffA);
        PG8_STAGE(PG8_SB(1, 0), cB + kstep, voffB); PG8_STAGE(PG8_SA(1, 0), cA + kstep, voffA); PG8_STAGE(PG8_SB(1, 1), cB + hstepB + kstep, voffB);
        if (wr == 1) PG8_BAR;
        PG8_WAIT_V(8); PG8_BAR;
        PG8_WAIT_V(6); PG8_BAR;
    } else {
        PG8_STAGE(PG8_SB(0, 0), cB, voffB); PG8_STAGE(PG8_SA(0, 0), cA, voffA); PG8_STAGE(PG8_SB(0, 1), cB + hstepB, voffB); PG8_STAGE(PG8_SA(0, 1), cA + hstepA, voffA);
        if (wr == 1) PG8_BAR;
        PG8_WAIT_V(4); PG8_BAR;
        PG8_STAGE(PG8_SB(1, 0), cB + kstep, voffB); PG8_STAGE(PG8_SA(1, 0), cA + kstep, voffA); PG8_STAGE(PG8_SB(1, 1), cB + hstepB + kstep, voffB);
        PG8_WAIT_V(6); PG8_BAR;
    }
    E.init_finish(acc, ini);
    for (;;) {
        const bool has_next = S.next(ui + 1, nxt);
        const char* nA = has_next ? (const char*)g.A + (size_t)nxt.pm * tstepA : cA; const char* nB = has_next ? (const char*)g.Bt + (size_t)nxt.pn * tstepB : cB;
        for (int t = 0; t < nt; t += 2) {
            const bool last = (t == nt - 2);
            const char* a1 = cA + (size_t)(t + 1) * kstep;
            const char* a2 = last ? nA : cA + (size_t)(t + 2) * kstep; const char* b2 = last ? nB : cB + (size_t)(t + 2) * kstep;
            const char* a3 = a2 + kstep; const char* b3 = b2 + kstep;
            if (last && has_next) E.prep(nxt, ui + 1, wid, lane);
            if constexpr (SP2) {
            PG8_LDB(B0, 0, 0); PG8_LDB(B1, 0, 1); PG8_SCHED; PG8_LDA(At, 0, 0); PG8_STAGE(PG8_SA(1, 1), a1 + hstepA, voffA);
            PG8_WAIT_V(8); PG8_WAIT_L(0); PG8_BAR; PG8_MMA(0, 0, At, B0); PG8_MMA(0, 1, At, B1); PG8_BAR; PG8_SCHED;
            PG8_LDA(At, 0, 1); PG8_STAGE(PG8_SB(0, 0), b2, voffB); PG8_STAGE(PG8_SB(0, 1), b2 + hstepB, voffB); PG8_STAGE(PG8_SA(0, 0), a2, voffA);
            PG8_WAIT_V(8); PG8_WAIT_L(0); PG8_BAR; PG8_MMA(1, 0, At, B0); PG8_MMA(1, 1, At, B1); PG8_BAR; PG8_SCHED;
            PG8_LDB(B0, 1, 0); PG8_LDB(B1, 1, 1); PG8_SCHED; PG8_LDA(At, 1, 0); PG8_STAGE(PG8_SA(0, 1), a2 + hstepA, voffA);
            PG8_WAIT_V(8); PG8_WAIT_L(0); PG8_BAR; PG8_MMA(0, 0, At, B0); PG8_MMA(0, 1, At, B1); PG8_BAR; PG8_SCHED;
            PG8_LDA(At, 1, 1); PG8_STAGE(PG8_SB(1, 0), b3, voffB); PG8_STAGE(PG8_SB(1, 1), b3 + hstepB, voffB); PG8_STAGE(PG8_SA(1, 0), a3, voffA);
            PG8_WAIT_V(8); PG8_WAIT_L(0); PG8_BAR; PG8_MMA(1, 0, At, B0); PG8_MMA(1, 1, At, B1); PG8_BAR; PG8_SCHED;
            } else {
            PG8_LDB(B0, 0, 0); PG8_SCHED; PG8_LDA(At, 0, 0); PG8_STAGE(PG8_SA(1, 1), a1 + hstepA, voffA);
            PG8_WAIT_L(8); PG8_BAR; PG8_WAIT_L(0); PG8_MMA(0, 0, At, B0); PG8_BAR; PG8_SCHED;
            PG8_LDB(B1, 0, 1); PG8_STAGE(PG8_SB(0, 0), b2, voffB);
            PG8_BAR; PG8_WAIT_L(0); PG8_MMA(0, 1, At, B1); PG8_BAR;
            PG8_LDA(At, 0, 1); PG8_STAGE(PG8_SA(0, 0), a2, voffA);
            PG8_BAR; PG8_WAIT_L(0); PG8_MMA(1, 0, At, B0); PG8_BAR; PG8_SCHED;
            PG8_STAGE(PG8_SB(0, 1), b2 + hstepB, voffB);
            PG8_WAIT_V(6); PG8_BAR; PG8_MMA(1, 1, At, B1); PG8_BAR;
            PG8_LDB(B0, 1, 0); PG8_SCHED; PG8_LDA(At, 1, 0); PG8_STAGE(PG8_SA(0, 1), a2 + hstepA, voffA);
            PG8_WAIT_L(8); PG8_BAR; PG8_WAIT_L(0); PG8_MMA(0, 0, At, B0); PG8_BAR; PG8_SCHED;
            PG8_LDB(B1, 1, 1); PG8_STAGE(PG8_SB(1, 0), b3, voffB);
            PG8_BAR; PG8_WAIT_L(0); PG8_MMA(0, 1, At, B1); PG8_BAR;
            PG8_LDA(At, 1, 1); PG8_STAGE(PG8_SA(1, 0), a3, voffA);
            PG8_BAR; PG8_WAIT_L(0); PG8_MMA(1, 0, At, B0); PG8_BAR; PG8_SCHED;
            PG8_STAGE(PG8_SB(1, 1), b3 + hstepB, voffB);
            PG8_WAIT_V(6); PG8_BAR; PG8_MMA(1, 1, At, B1); PG8_BAR;
            }
        }
        if constexpr (ALIGN_EPI) { if (wr == 0) PG8_BAR; }
        E(acc, cur, ui, wr, wc, fr, fq);
        if (!has_next) break;
        E.init_load(ini, nxt, wr, wc); E.init_finish(acc, ini);
        cur = nxt; cA = nA; cB = nB; ++ui;
        if constexpr (ALIGN_EPI) { if (wr == 1) PG8_BAR; }
    }
    PG8_WAIT_V(0);
    if constexpr (!ALIGN_EPI) { if (wr == 0) PG8_BAR; }
    PG8_BAR;
#undef PG8_SA
#undef PG8_SB
#undef PG8_STAGE
#undef PG8_LDA
#undef PG8_LDB
#undef PG8_MMA
#undef PG8_WAIT_V
#undef PG8_WAIT_L
#undef PG8_BAR
#undef PG8_SCHED
}

struct ZeroInit {
    struct InitT {};
    __device__ __forceinline__ void init_load(InitT&, const Unit&, int, int) const {}
    __device__ __forceinline__ void init_finish(f32x4 (&acc)[2][2][4][2], const InitT&) const {
#pragma unroll
        for (int a = 0; a < 2; ++a)
#pragma unroll
            for (int b = 0; b < 2; ++b)
#pragma unroll
                for (int m = 0; m < 4; ++m)
#pragma unroll
                    for (int n = 0; n < 2; ++n) acc[a][b][m][n] = (f32x4){0.f, 0.f, 0.f, 0.f};
    }
};
struct ResidInit {
    struct InitT { u32x4 r[2][4][2]; };
    __device__ __forceinline__ void resid_load(InitT& it, const bf16_t* xin, const Unit& u, int wr, int wc) const {
        const int lane_ = lane_id(), fr = lane_ & 15, fq = lane_ >> 4; const int col0 = u.pn * BM + wc * 32 + 8 * fq;
#pragma unroll
        for (int ai = 0; ai < 2; ++ai)
#pragma unroll
            for (int m = 0; m < 4; ++m)
#pragma unroll
                for (int bj = 0; bj < 2; ++bj) it.r[ai][m][bj] = *(const u32x4*)(xin + (size_t)(u.pm * BM + wr * HALF + ai * 64 + m * 16 + fr) * DM + col0 + bj * HALF);
    }
    __device__ __forceinline__ void init_finish(f32x4 (&acc)[2][2][4][2], const InitT& it) const {
#pragma unroll
        for (int ai = 0; ai < 2; ++ai)
#pragma unroll
            for (int m = 0; m < 4; ++m)
#pragma unroll
                for (int bj = 0; bj < 2; ++bj) { const u32x4 r = it.r[ai][m][bj];
                    acc[ai][bj][m][0] = (f32x4){__builtin_bit_cast(float, r.x << 16), __builtin_bit_cast(float, r.x & 0xffff0000u), __builtin_bit_cast(float, r.y << 16), __builtin_bit_cast(float, r.y & 0xffff0000u)};
                    acc[ai][bj][m][1] = (f32x4){__builtin_bit_cast(float, r.z << 16), __builtin_bit_cast(float, r.z & 0xffff0000u), __builtin_bit_cast(float, r.w << 16), __builtin_bit_cast(float, r.w & 0xffff0000u)}; }
    }
};
template <int MODE> struct EpiRow : ZeroInit {
    static constexpr int PERM = 2;
    bf16_t* O; int ldc; const float* ssq; int nparts; PG8_LAS float* aux; const float* rope; PG8_LAS unsigned char* stg;
    __device__ __forceinline__ void prep(const Unit& u, int ui, int wid, int) const {
        const int lane = lane_id();
        if (wid < 4) {
#pragma unroll
            for (int p = 0; p < 4; ++p)
            __builtin_amdgcn_global_load_lds((const unsigned*)(ssq + (size_t)p * MT + u.pm * BM + wid * 64 + lane), (PG8_LAS unsigned*)(aux + ((ui & 1) * 4 + p) * 256 + wid * 64), 4, 0, 0); }
    }
    __device__ __forceinline__ void operator()(const f32x4 (&acc)[2][2][4][2], const Unit& u, int ui, int wr, int wc, int, int) const {
        typedef unsigned u32x2 __attribute__((ext_vector_type(2)));
        const int lane_ = lane_id(), fr = lane_ & 15, fq = lane_ >> 4;
        const PG8_LAS float* ax = aux + (ui & 1) * 1024;
        PG8_LAS unsigned char* sw = stg + (wr * 4 + wc) * 1280 + fr * 80 + (fq >> 1) * 32 + (fq & 1) * 8; const PG8_LAS unsigned char* sr = stg + (wr * 4 + wc) * 1280 + (lane_ >> 2) * 80 + (lane_ & 3) * 16;
        float rs[8];
#pragma unroll
        for (int b = 0; b < 8; ++b) { const int rl = wr * HALF + b * 16 + fr; const float ssum = (ax[rl] + ax[256 + rl]) + (ax[512 + rl] + ax[768 + rl]); rs[b] = __builtin_amdgcn_rsqf(ssum * (1.0f / DM) + EPS); }
        u32x4 wt = (u32x4){0u, 0u, 0u, 0u}; bf16_t* tp = O; f32x4 cP[2][2];
        const bool dorope = (MODE == 1) && (u.pn <= 1) && ((wc & 1) == 0);
#pragma unroll
        for (int ai = 0; ai < 2; ++ai)
#pragma unroll
            for (int m = 0; m < 4; ++m) {
                const float rsv = rs[ai * 4 + m];
                bf16_t* rowp = O + (size_t)u.pn * ZBLK + (size_t)(u.pm * BM + wr * HALF + ai * 64 + m * 16 + (lane_ >> 2)) * ldc + wc * 32 + 8 * (lane_ & 3);
                if ((m & 1) == 0) {
#pragma unroll
                    for (int b = 0; b < 2; ++b) { cP[b][0] = (f32x4){1.f, 0.f, 1.f, 0.f}; cP[b][1] = cP[b][0]; }
                    if (MODE == 1) { if (dorope) { if (fq < 2) {
#pragma unroll
                        for (int b = 0; b < 2; ++b) { const int row = u.pm * BM + wr * HALF + ai * 64 + (m + b) * 16 + fr; const int pos = row < MP ? (row & (SEQ - 1)) : (SEQ + ((row - MP) & (ST - 1)));
                            const f32x4* rp = (const f32x4*)(rope + (size_t)pos * 16 + 8 * fq); cP[b][0] = rp[0]; cP[b][1] = rp[1]; } } } }
                }
                const f32x4 cA = cP[m & 1][0], cB = cP[m & 1][1];
#pragma unroll
                for (int bj = 0; bj < 2; ++bj) {
                    f32x4 v0 = acc[ai][bj][m][0] * rsv, v1 = acc[ai][bj][m][1] * rsv;
                    if (MODE == 1) { if (dorope && (u.pn == 0 || bj == 0)) {
                        const f32x4 lo = v0, hi = v1;
                        v0 = (f32x4){lo[0] * cA[0] - hi[0] * cA[1], lo[1] * cA[2] - hi[1] * cA[3], lo[2] * cB[0] - hi[2] * cB[1], lo[3] * cB[2] - hi[3] * cB[3]};
                        v1 = (f32x4){hi[0] * cA[0] + lo[0] * cA[1], hi[1] * cA[2] + lo[1] * cA[3], hi[2] * cB[0] + lo[2] * cB[1], hi[3] * cB[2] + lo[3] * cB[3]};
                    } }
                    u32x2 wa, wb; wa.x = cvt_pk_bf16(v0[0], v0[1]); wa.y = cvt_pk_bf16(v0[2], v0[3]); wb.x = cvt_pk_bf16(v1[0], v1[1]); wb.y = cvt_pk_bf16(v1[2], v1[3]);
                    if (ai + m + bj > 0) asm volatile("s_waitcnt lgkmcnt(0)\n\tglobal_store_dwordx4 %0, %1, off\n\ts_nop 1" :: "v"(tp), "v"(wt) : "memory");
                    *(PG8_LAS u32x2*)sw = wa; *(PG8_LAS u32x2*)(sw + 16) = wb; wt = *(const PG8_LAS u32x4*)sr; tp = rowp + bj * HALF;
                }
            }
        asm volatile("s_waitcnt lgkmcnt(0)\n\tglobal_store_dwordx4 %0, %1, off\n\ts_nop 1" :: "v"(tp), "v"(wt) : "memory");
    }
};
__device__ __forceinline__ float dpp_ror1(float v) { return __builtin_bit_cast(float, __builtin_amdgcn_mov_dpp(__builtin_bit_cast(int, v), 0x121, 0xf, 0xf, true)); }
__device__ __forceinline__ float dpp_ror2(float v) { return __builtin_bit_cast(float, __builtin_amdgcn_mov_dpp(__builtin_bit_cast(int, v), 0x122, 0xf, 0xf, true)); }
__device__ __forceinline__ float ua_shr1(float old, float v) { asm volatile("s_nop 1\n\tv_mov_b32_dpp %0, %1 row_shr:1 row_mask:0xf bank_mask:0xf" : "+v"(old) : "v"(v)); return old; }
struct EpiUpAct : ZeroInit {
    static constexpr bool PERM = true;
    bf16_t* act; const float* ssq; int nparts; PG8_LAS float* aux; PG8_LAS f32x4* xch; PG8_LAS float* wl; const float* fcw; float* head; float* tail; float* fout; PG8_LAS unsigned char* stg;
    __device__ __forceinline__ void prep(const Unit& u, int ui, int wid, int) const {
        const int lane = lane_id();
        if (wid < 4) {
#pragma unroll
            for (int p = 0; p < 4; ++p)
            __builtin_amdgcn_global_load_lds((const unsigned*)(ssq + (size_t)p * MT + u.pm * BM + wid * 64 + lane), (PG8_LAS unsigned*)(aux + ((ui & 1) * 4 + p) * 256 + wid * 64), 4, 0, 0); }
        else {
#pragma unroll
            for (int k = 0; k < 3; ++k) { const int c = (wid - 4) * 3 + k, j = c >> 2, bj = (c >> 1) & 1, hf = c & 1;
                __builtin_amdgcn_global_load_lds((const unsigned*)(fcw + (size_t)j * NUP + bj * DFF + u.pn * HALF + hf * 64 + lane), (PG8_LAS unsigned*)(wl + (ui & 1) * 768 + c * 64), 4, 0, 0); } }
    }
    __device__ __forceinline__ void operator()(const f32x4 (&acc)[2][2][4][2], const Unit& u, int ui, int wr, int wc, int, int) const {
        typedef float f32x2 __attribute__((ext_vector_type(2)));
        const int lane_ = lane_id(), fr = lane_ & 15, fq = lane_ >> 4;
        const PG8_LAS float* ax = aux + (ui & 1) * 1024; const PG8_LAS float* wq = wl + (ui & 1) * 768;
        float rs[8];
        { const int rl = wr * HALF + 8 * fr;
#pragma unroll
          for (int h = 0; h < 2; ++h) { const f32x4 p0 = *(const PG8_LAS f32x4*)(ax + rl + 4 * h), p1 = *(const PG8_LAS f32x4*)(ax + 256 + rl + 4 * h), p2 = *(const PG8_LAS f32x4*)(ax + 512 + rl + 4 * h), p3 = *(const PG8_LAS f32x4*)(ax + 768 + rl + 4 * h);
#pragma unroll
              for (int k = 0; k < 4; ++k) rs[4 * h + k] = __builtin_amdgcn_rsqf(((p0[k] + p1[k]) + (p2[k] + p3[k])) * (1.0f / DM) + EPS); } }
        const int cl = wc * 32 + 8 * fq;
        if (fr == 15) {
#pragma unroll
            for (int bj = 0; bj < 2; ++bj)
#pragma unroll
                for (int n = 0; n < 2; ++n)
#pragma unroll
                    for (int k = 0; k < 2; ++k) { const f32x4 x = acc[1][bj][2 + k][n] * rs[6 + k];
                        if (wr == 0) xch[((bj * 4 + wc) * 2 + n) * 8 + fq * 2 + k] = x;
                        else { *(f32x4*)(tail + (size_t)(u.pm * 2 + k) * NUP + u.pn * BM + bj * HALF + cl + 4 * n) = x;
                            if ((u.pm & 7) == 7) *(f32x4*)(fout + (size_t)((u.pm >> 3) * 4 + k) * NUP + bj * DFF + u.pn * HALF + cl + 4 * n) = x; } }
        }
        if (fr == 0 && wr == 0) {
#pragma unroll
            for (int bj = 0; bj < 2; ++bj)
#pragma unroll
                for (int n = 0; n < 2; ++n)
#pragma unroll
                    for (int k = 0; k < 2; ++k) *(f32x4*)(head + (size_t)(u.pm * 2 + k) * NUP + u.pn * BM + bj * HALF + cl + 4 * n) = acc[0][bj][k][n] * rs[k];
        }
        asm volatile("s_waitcnt lgkmcnt(0)" ::: "memory"); __builtin_amdgcn_s_barrier(); asm volatile("" ::: "memory");
        PG8_LAS unsigned char* sw = stg + (wr * 4 + wc) * 1280 + fr * 80 + fq * 16; const PG8_LAS unsigned char* sr = stg + (wr * 4 + wc) * 1280 + (lane_ >> 2) * 80 + (lane_ & 3) * 16;
        bf16_t* arow = act + (size_t)(u.pm * BM + wr * HALF + 8 * (lane_ >> 2)) * DFF + u.pn * HALF + wc * 32 + 8 * (lane_ & 3);
        unsigned pk0[8][2]; u32x4 wt = (u32x4){0u, 0u, 0u, 0u};
#define UA_SHR1(old_, v_) ua_shr1((old_), (v_))
#pragma unroll
        for (int n = 0; n < 2; ++n) {
            f32x4 wg[3], wv[3];
#pragma unroll
            for (int j = 0; j < 3; ++j) { wg[j] = *(const PG8_LAS f32x4*)(wq + (j * 2 + 0) * 128 + cl + 4 * n); wv[j] = *(const PG8_LAS f32x4*)(wq + (j * 2 + 1) * 128 + cl + 4 * n); }
            f32x4 hg6 = (f32x4){0.f, 0.f, 0.f, 0.f}, hg7 = hg6, hv6 = hg6, hv7 = hg6;
            if (wr == 1 && fr == 0) { hg6 = xch[((0 * 4 + wc) * 2 + n) * 8 + fq * 2 + 0]; hg7 = xch[((0 * 4 + wc) * 2 + n) * 8 + fq * 2 + 1];
                                      hv6 = xch[((1 * 4 + wc) * 2 + n) * 8 + fq * 2 + 0]; hv7 = xch[((1 * 4 + wc) * 2 + n) * 8 + fq * 2 + 1]; }
            unsigned pkn[8][2];
#pragma unroll
            for (int ep = 0; ep < 2; ++ep) {
                const int e0 = 2 * ep, e1 = 2 * ep + 1;
                f32x2 xg[8], xv[8];
#pragma unroll
                for (int blk = 0; blk < 8; ++blk) { const f32x4 ag = acc[blk >> 2][0][blk & 3][n], av = acc[blk >> 2][1][blk & 3][n];
                    xg[blk] = (f32x2){ag[e0], ag[e1]} * rs[blk]; xv[blk] = (f32x2){av[e0], av[e1]} * rs[blk]; }
                const f32x2 sg7 = (f32x2){UA_SHR1(hg7[e0], xg[7][0]), UA_SHR1(hg7[e1], xg[7][1])}, sg6 = (f32x2){UA_SHR1(hg6[e0], xg[6][0]), UA_SHR1(hg6[e1], xg[6][1])};
                const f32x2 sv7 = (f32x2){UA_SHR1(hv7[e0], xv[7][0]), UA_SHR1(hv7[e1], xv[7][1])}, sv6 = (f32x2){UA_SHR1(hv6[e0], xv[6][0]), UA_SHR1(hv6[e1], xv[6][1])};
                const f32x2 g2 = (f32x2){wg[2][e0], wg[2][e1]}, g1 = (f32x2){wg[1][e0], wg[1][e1]}, g0 = (f32x2){wg[0][e0], wg[0][e1]};
                const f32x2 v2 = (f32x2){wv[2][e0], wv[2][e1]}, v1 = (f32x2){wv[1][e0], wv[1][e1]}, v0 = (f32x2){wv[0][e0], wv[0][e1]};
#pragma unroll
                for (int blk = 0; blk < 8; ++blk) {
                    const f32x2 pg1 = blk >= 1 ? xg[blk >= 1 ? blk - 1 : 0] : sg7, pg2 = blk >= 2 ? xg[blk >= 2 ? blk - 2 : 0] : (blk == 1 ? sg7 : sg6);
                    const f32x2 pv1 = blk >= 1 ? xv[blk >= 1 ? blk - 1 : 0] : sv7, pv2 = blk >= 2 ? xv[blk >= 2 ? blk - 2 : 0] : (blk == 1 ? sv7 : sv6);
                    const f32x2 yg = g2 * xg[blk] + g1 * pg1 + g0 * pg2;
                    const f32x2 yv = v2 * xv[blk] + v1 * pv1 + v0 * pv2;
                    const f32x2 t = yg * -1.4426950408889634f;
                    const f32x2 d = (f32x2){__builtin_amdgcn_exp2f(t[0]), __builtin_amdgcn_exp2f(t[1])} + 1.f;
                    const f32x2 a = yg * yv * (f32x2){__builtin_amdgcn_rcpf(d[0]), __builtin_amdgcn_rcpf(d[1])};
                    pkn[blk][ep] = cvt_pk_bf16(a[0], a[1]);
                    if (n == 1 && ep == 1) {
                        if (blk > 0) { bf16_t* sp_ = arow + (size_t)(blk - 1) * DFF; asm volatile("s_waitcnt lgkmcnt(0)\n\tglobal_store_dwordx4 %0, %1, off nt sc1\n\ts_nop 1" :: "v"(sp_), "v"(wt) : "memory"); }
                        u32x4 w; w.x = pk0[blk][0]; w.y = pk0[blk][1]; w.z = pkn[blk][0]; w.w = pkn[blk][1];
                        *(PG8_LAS u32x4*)sw = w; wt = *(const PG8_LAS u32x4*)sr;
                    }
                }
            }
            if (n == 0) {
#pragma unroll
                for (int blk = 0; blk < 8; ++blk) { pk0[blk][0] = pkn[blk][0]; pk0[blk][1] = pkn[blk][1]; }
            } else { bf16_t* sp_ = arow + (size_t)7 * DFF; asm volatile("s_waitcnt lgkmcnt(0)\n\tglobal_store_dwordx4 %0, %1, off nt sc1\n\ts_nop 1" :: "v"(sp_), "v"(wt) : "memory"); }
        }
#undef UA_SHR1
    }
};
struct EpiRes : ResidInit {
    static constexpr bool PERM = true;
    const bf16_t* xin; bf16_t* xout; float* ssq_out; PG8_LAS float* red; PG8_LAS unsigned char* stg;
    __device__ __forceinline__ void prep(const Unit&, int, int, int) const {}
    __device__ __forceinline__ void init_load(InitT& it, const Unit& u, int wr, int wc) const { resid_load(it, xin, u, wr, wc); }
    __device__ __forceinline__ void operator()(const f32x4 (&acc)[2][2][4][2], const Unit& u, int ui, int wr, int wc, int, int) const {
        const int lane_ = lane_id(), fr = lane_ & 15, fq = lane_ >> 4;
        PG8_LAS unsigned char* sw = stg + (wr * 4 + wc) * 1280 + fr * 80 + fq * 16; const PG8_LAS unsigned char* sr = stg + (wr * 4 + wc) * 1280 + (lane_ >> 2) * 80 + (lane_ & 3) * 16;
        bf16_t* xbase = xout + (size_t)(u.pm * BM + wr * HALF + (lane_ >> 2)) * DM + u.pn * BM + wc * 32 + 8 * (lane_ & 3);
        u32x4 wt = (u32x4){0u, 0u, 0u, 0u}; bf16_t* tp = xbase;
#pragma unroll
        for (int ai = 0; ai < 2; ++ai) {
            const int rl0 = wr * HALF + ai * 64 + fr;
#pragma unroll
            for (int m = 0; m < 4; ++m) {
                float sq = 0.f;
#pragma unroll
                for (int bj = 0; bj < 2; ++bj) {
                    const f32x4 v0 = acc[ai][bj][m][0], v1 = acc[ai][bj][m][1];
                    u32x4 w; w.x = cvt_pk_bf16(v0[0], v0[1]); w.y = cvt_pk_bf16(v0[2], v0[3]); w.z = cvt_pk_bf16(v1[0], v1[1]); w.w = cvt_pk_bf16(v1[2], v1[3]);
                    if (ai + m + bj > 0) asm volatile("s_waitcnt lgkmcnt(0)\n\tglobal_store_dwordx4 %0, %1, off\n\ts_nop 1" :: "v"(tp), "v"(wt) : "memory");
                    *(PG8_LAS u32x4*)sw = w; wt = *(const PG8_LAS u32x4*)sr; tp = xbase + (size_t)(ai * 64 + m * 16) * DM + bj * HALF;
                    const float q0 = __builtin_bit_cast(float, w.x << 16), q1 = __builtin_bit_cast(float, w.x & 0xffff0000u), q2 = __builtin_bit_cast(float, w.y << 16), q3 = __builtin_bit_cast(float, w.y & 0xffff0000u);
                    const float q4 = __builtin_bit_cast(float, w.z << 16), q5 = __builtin_bit_cast(float, w.z & 0xffff0000u), q6 = __builtin_bit_cast(float, w.w << 16), q7 = __builtin_bit_cast(float, w.w & 0xffff0000u);
                    sq += (q0 * q0 + q1 * q1) + (q2 * q2 + q3 * q3) + (q4 * q4 + q5 * q5) + (q6 * q6 + q7 * q7);
                }
                sq += __shfl_xor(sq, 16); sq += __shfl_xor(sq, 32);
                if (fq == 0) red[wc * 256 + rl0 + m * 16] = sq;
            }
        }
        asm volatile("s_waitcnt lgkmcnt(0)\n\tglobal_store_dwordx4 %0, %1, off\n\ts_nop 1" :: "v"(tp), "v"(wt) : "memory");
        asm volatile("s_waitcnt lgkmcnt(0)" ::: "memory"); __builtin_amdgcn_s_barrier(); asm volatile("" ::: "memory");
        if (wr == 0) { const int t = wc * 64 + lane_; ssq_out[(size_t)u.pn * MT + u.pm * BM + t] = (red[t] + red[256 + t]) + (red[512 + t] + red[768 + t]); }
    }
};
struct EpiFinal : ResidInit {
    static constexpr bool PERM = true;
    const bf16_t* xin; float* yout; const float* gfin; float* xbuf; unsigned* cnt; PG8_LAS float* red; PG8_LAS unsigned char* stg;
    __device__ __forceinline__ void prep(const Unit&, int, int, int) const {}
    __device__ __forceinline__ void init_load(InitT& it, const Unit& u, int wr, int wc) const { resid_load(it, xin, u, wr, wc); }
    __device__ __forceinline__ void operator()(const f32x4 (&acc)[2][2][4][2], const Unit& u, int ui, int wr, int wc, int, int) const {
        const int lane_ = lane_id(), fr = lane_ & 15, fq = lane_ >> 4;
        const int col0 = u.pn * BM + wc * 32 + 8 * fq;
        f32x4 gv[2][2];
#pragma unroll
        for (int bj = 0; bj < 2; ++bj) { gv[bj][0] = *(const f32x4*)(gfin + col0 + bj * HALF); gv[bj][1] = *(const f32x4*)(gfin + col0 + bj * HALF + 4); }
#define EF_X(ai, m, bj, v0, v1) const f32x4 v0 = acc[ai][bj][m][0], v1 = acc[ai][bj][m][1];
#pragma unroll
        for (int ai = 0; ai < 2; ++ai)
#pragma unroll
            for (int m = 0; m < 4; ++m) { float sq = 0.f;
#pragma unroll
                for (int bj = 0; bj < 2; ++bj) { EF_X(ai, m, bj, v0, v1)
                    sq += (v0[0] * v0[0] + v0[1] * v0[1]) + (v0[2] * v0[2] + v0[3] * v0[3]) + (v1[0] * v1[0] + v1[1] * v1[1]) + (v1[2] * v1[2] + v1[3] * v1[3]); }
                sq += __shfl_xor(sq, 16); sq += __shfl_xor(sq, 32);
                if (fq == 0) red[wc * 256 + wr * HALF + ai * 64 + m * 16 + fr] = sq; }
        asm volatile("s_waitcnt lgkmcnt(0)" ::: "memory"); __builtin_amdgcn_s_barrier(); asm volatile("" ::: "memory");
        const int t = wc * 64 + lane_;
        if (wr == 0) {
            const float sp = (red[t] + red[256 + t]) + (red[512 + t] + red[768 + t]);
            __hip_atomic_store(xbuf + (size_t)(u.pm * BM + t) * 4 + u.pn, sp, __ATOMIC_RELAXED, __HIP_MEMORY_SCOPE_AGENT);
            asm volatile("s_waitcnt vmcnt(0)" ::: "memory");
            if (lane_ == 0) __hip_atomic_fetch_add(cnt + 64 * u.pm, 1u, __ATOMIC_RELAXED, __HIP_MEMORY_SCOPE_AGENT);
            if (wc == 0) {
                unsigned spins = 0;
                while ((unsigned)__builtin_amdgcn_readfirstlane(__hip_atomic_load(cnt + 64 * u.pm, __ATOMIC_RELAXED, __HIP_MEMORY_SCOPE_AGENT)) < 16u) { __builtin_amdgcn_s_sleep(2); if (++spins > (1u << 22)) break; }
                __builtin_amdgcn_fence(__ATOMIC_ACQUIRE, "agent");
            }
        }
        asm volatile("s_waitcnt vmcnt(0) lgkmcnt(0)" ::: "memory"); __builtin_amdgcn_s_barrier(); asm volatile("" ::: "memory");
        if (wr == 0) {
            const float* sl = xbuf + (size_t)(u.pm * BM + t) * 4;
            const float tot = (__hip_atomic_load(sl, __ATOMIC_RELAXED, __HIP_MEMORY_SCOPE_AGENT) + __hip_atomic_load(sl + 1, __ATOMIC_RELAXED, __HIP_MEMORY_SCOPE_AGENT))
                            + (__hip_atomic_load(sl + 2, __ATOMIC_RELAXED, __HIP_MEMORY_SCOPE_AGENT) + __hip_atomic_load(sl + 3, __ATOMIC_RELAXED, __HIP_MEMORY_SCOPE_AGENT));
            red[t] = __builtin_amdgcn_rsqf(tot * (1.0f / DM) + EPS);
        }
        asm volatile("s_waitcnt lgkmcnt(0)" ::: "memory"); __builtin_amdgcn_s_barrier(); asm volatile("" ::: "memory");
        PG8_LAS unsigned char* sw = stg + (wr * 4 + wc) * 2304 + fr * 144 + fq * 32; const PG8_LAS unsigned char* sr = stg + (wr * 4 + wc) * 2304 + (lane_ >> 3) * 144 + (lane_ & 7) * 16;
        float* ybase = yout + (size_t)(u.pm * BM + wr * HALF + (lane_ >> 3)) * DM + u.pn * BM + wc * 32 + 4 * (lane_ & 7);
        f32x4 ta = (f32x4){0.f, 0.f, 0.f, 0.f}, tb = ta; float* tp = ybase;
#pragma unroll
        for (int ai = 0; ai < 2; ++ai)
#pragma unroll
            for (int m = 0; m < 4; ++m) { const int rl = wr * HALF + ai * 64 + m * 16 + fr; const float rs = red[rl];
#pragma unroll
                for (int bj = 0; bj < 2; ++bj) { EF_X(ai, m, bj, v0, v1)
                    const f32x4 o0 = v0 * rs * gv[bj][0], o1 = v1 * rs * gv[bj][1];
                    if (ai + m + bj > 0) asm volatile("s_waitcnt lgkmcnt(0)\n\tglobal_store_dwordx4 %0, %1, off\n\tglobal_store_dwordx4 %2, %3, off\n\ts_nop 1" :: "v"(tp), "v"(ta), "v"(tp + (size_t)8 * DM), "v"(tb) : "memory");
                    *(PG8_LAS f32x4*)sw = o0; *(PG8_LAS f32x4*)(sw + 16) = o1; ta = *(const PG8_LAS f32x4*)sr; tb = *(const PG8_LAS f32x4*)(sr + 8 * 144);
                    tp = ybase + (size_t)(ai * 64 + m * 16) * DM + bj * HALF; } }
        asm volatile("s_waitcnt lgkmcnt(0)\n\tglobal_store_dwordx4 %0, %1, off\n\tglobal_store_dwordx4 %2, %3, off\n\ts_nop 1" :: "v"(tp), "v"(ta), "v"(tp + (size_t)8 * DM), "v"(tb) : "memory");
#undef EF_X
    }
};
}

constexpr size_t MiB = 1u << 20;
constexpr size_t WS_CTL = 0, CTL_ZERO_BYTES = 1 * MiB;
constexpr size_t WS_ROPE = 1 * MiB;
constexpr size_t WS_WIN = 2 * MiB, WS_WOUT = 10 * MiB, WS_WUP = 14 * MiB, WS_WDN = 36 * MiB;
constexpr size_t WS_SSQA = 47 * MiB, WS_SSQB = 50 * MiB;
constexpr size_t WS_HEAD = 53 * MiB, WS_TAIL = 59 * MiB;
constexpr size_t WS_XB = 65 * MiB;
constexpr size_t WS_Z = 130 * MiB;
constexpr size_t WS_MIX = 260 * MiB;
constexpr size_t WS_ACT = 130 * MiB;
constexpr size_t WS_UPS = 488 * MiB;
constexpr size_t WS_END = 492 * MiB;
static_assert(WS_ACT + (size_t)MT * DFF * 2 <= WS_UPS && WS_UPS + (size_t)MS * NUP * 2 <= WS_END && WS_MIX + (size_t)MT * DM * 2 <= WS_END && WS_Z + (size_t)MT * NPROJ * 2 <= WS_MIX && WS_XB + (size_t)MT * DM * 2 <= WS_Z, "ws map");
static_assert(WS_HEAD + (size_t)128 * 2 * NUP * 4 <= WS_TAIL && WS_TAIL + (size_t)128 * 2 * NUP * 4 <= WS_XB && WS_SSQA + (size_t)16 * MT * 4 <= WS_SSQB && WS_SSQB + (size_t)16 * MT * 4 <= WS_TAIL, "ws map 2");
constexpr int CW_TMO = 0, CW_BAR = 4096, CW_PANEL = 16384;

constexpr int RING_BYTES = 131072;
constexpr int AUX_OFF = RING_BYTES;
constexpr int LDS_BYTES = 163840;
constexpr int MISC_OFF = LDS_BYTES - 128;

#define GAS __attribute__((address_space(1)))
#define LAS __attribute__((address_space(3)))
typedef unsigned short bf16;
typedef unsigned v4u __attribute__((ext_vector_type(4), may_alias));
typedef unsigned v2u __attribute__((ext_vector_type(2), may_alias));
typedef float f32x4 __attribute__((ext_vector_type(4)));
#define LDS_WAIT() asm volatile("s_waitcnt lgkmcnt(0)" ::: "memory")
__device__ __forceinline__ unsigned f2bf(float f) { unsigned u = __builtin_bit_cast(unsigned, f); return (u + 0x7fffu + ((u >> 16) & 1u)) >> 16; }
__device__ __forceinline__ unsigned pk2(float lo, float hi) { return f2bf(lo) | (f2bf(hi) << 16); }
__device__ __forceinline__ float bf2f(unsigned h) { return __builtin_bit_cast(float, h << 16); }
__device__ __forceinline__ float bflo(unsigned w) { return __builtin_bit_cast(float, w << 16); }
__device__ __forceinline__ float bfhi(unsigned w) { return __builtin_bit_cast(float, w & 0xffff0000u); }
__device__ __forceinline__ float gelu_t(float x) { const float y2 = 2.302208198f * (x + 0.044715f * x * x * x);     const float e = __builtin_amdgcn_exp2f(y2); return x * (1.f - __builtin_amdgcn_rcpf(e + 1.f)); }
__device__ __forceinline__ float silu_f(float x) { return x * __builtin_amdgcn_rcpf(1.f + __builtin_amdgcn_exp2f(-1.4426950408889634f * x)); }
__device__ __forceinline__ float wave_sum(float v) {
#pragma unroll
    for (int o = 1; o < 64; o <<= 1) v += __shfl_xor(v, o);
    return v;
}

#define XB_TMO      128
#define XB_XCNT(j)  (256  + 64 * (j))
#define XB_XSUB(j)  (1280 + 64 * (j))
#define XB_XGEN(j)  (2304 + 64 * (j))
#define XB_TOP      3328
#define XB_TOPGEN   3392
#define XCD_BAR_WORDS 3456
#define XB_SPIN_CAP (1u << 18)
__device__ __forceinline__ unsigned xb_ld(unsigned* p)              { return __hip_atomic_load(p, __ATOMIC_RELAXED, __HIP_MEMORY_SCOPE_AGENT); }
__device__ __forceinline__ unsigned xb_add(unsigned* p, unsigned v) { return __hip_atomic_fetch_add(p, v, __ATOMIC_RELAXED, __HIP_MEMORY_SCOPE_AGENT); }
__device__ __forceinline__ unsigned xb_xcc_id() { return (unsigned)__builtin_amdgcn_s_getreg((3 << 11) | 20) & 0xFu; }
#define XB_SPIN(cond, bar) do { unsigned _sp = 0; while (cond) { __builtin_amdgcn_s_sleep(1); \
    if ((++_sp & 255u) == 0u) { if (xb_ld(&(bar)[XB_TMO])) break; if (_sp > XB_SPIN_CAP) { atomicAdd(&(bar)[XB_TMO], 1u); break; } } } } while (0)
struct XcdBarrier { unsigned* bar; unsigned x; volatile LAS unsigned* st; };
__device__ __forceinline__ XcdBarrier xcd_barrier_post(unsigned* bar, volatile LAS unsigned* st) {
    XcdBarrier b; b.bar = bar; b.x = xb_xcc_id(); b.st = st;
    if (threadIdx.x == 0) (void)xb_add(&bar[XB_XCNT(b.x)], 1u);
    return b;
}
__device__ __forceinline__ void xcd_barrier_complete(unsigned* bar, unsigned x, unsigned& nloc, unsigned& nx) {
    const unsigned G = gridDim.x * gridDim.y * gridDim.z;
    unsigned sum, cnt, mine, sp = 0u;
    for (;;) {
        sum = 0u; cnt = 0u; mine = 0u;
#pragma unroll
        for (unsigned j = 0; j < 16; ++j) { const unsigned c = xb_ld(&bar[XB_XCNT(j)]); sum += c; cnt += (c > 0u) ? 1u : 0u; mine = (j == x) ? c : mine; }
        if (sum == G) break;
        __builtin_amdgcn_s_sleep(1);
        if ((++sp & 255u) == 0u) { if (xb_ld(&bar[XB_TMO])) break; if (sp > XB_SPIN_CAP) { atomicAdd(&bar[XB_TMO], 1u); break; } }
    }
    nloc = mine > 0u ? mine : 1u; nx = cnt > 0u ? cnt : 1u;
}
__device__ __forceinline__ void xcd_barrier(const XcdBarrier& b, int wave) {
    asm volatile("s_waitcnt vmcnt(0)" ::: "memory");
    __syncthreads();
    if (wave == 0 && lane_id() == 0) {
        unsigned* bar = b.bar;
        __builtin_amdgcn_s_waitcnt(0);
        unsigned nloc = b.st[0], nx = b.st[1];
        if (nloc == 0u) { xcd_barrier_complete(bar, b.x, nloc, nx); b.st[0] = nloc; b.st[1] = nx; }
        const unsigned old = xb_add(&bar[XB_XSUB(b.x)], 1u);
        const unsigned gen = old / nloc;
        if (old + 1u == (gen + 1u) * nloc) {
            __builtin_amdgcn_fence(__ATOMIC_RELEASE, "agent");
            asm volatile("s_waitcnt vmcnt(0)" ::: "memory");
            const unsigned og = xb_add(&bar[XB_TOP], 1u);
            const unsigned tg = og / nx;
            if (og + 1u == (tg + 1u) * nx) xb_add(&bar[XB_TOPGEN], 1u);
            else XB_SPIN(xb_ld(&bar[XB_TOPGEN]) == tg, bar);
            __builtin_amdgcn_fence(__ATOMIC_ACQUIRE, "agent");
            xb_add(&bar[XB_XGEN(b.x)], 1u);
            asm volatile("s_waitcnt vmcnt(0)" ::: "memory");
        } else {
            XB_SPIN(xb_ld(&bar[XB_XGEN(b.x)]) == gen, bar);
            __builtin_amdgcn_fence(__ATOMIC_ACQUIRE, "agent");
            asm volatile("s_waitcnt vmcnt(0)" ::: "memory");
        }
    }
    __syncthreads();
}

struct Args { const float* in[23]; float* out; unsigned char* ws; };
enum { I_XP = 0, I_XS, I_CK, I_CV, I_SCONV, I_SPOOL, I_SFFN, I_GMIX, I_WIN, I_SINK, I_CONVW, I_LNG, I_LNB, I_GW, I_GB, I_PW, I_PSC, I_WOUT, I_GFFN, I_WUP, I_FCW, I_WDN, I_GFIN };

#define CAS __attribute__((address_space(4)))
__device__ __forceinline__ const CAS char* karg_base() { const CAS char* kp = (const CAS char*)__builtin_amdgcn_kernarg_segment_ptr(); asm volatile("" : "+s"(kp)); return kp; }
#define AIN(i) (*(const float* const CAS*)(karg_base() + 8 * (i)))
#define AOUT() (*(float* const CAS*)(karg_base() + 184))
#define AWS() (*(unsigned char* const CAS*)(karg_base() + 192))
template <bool UPPERM> __device__ __forceinline__ void p0_transpose_item(const float* W, int K, int N, const float* g, bf16* WT, LAS float* scr, int item, int lane) {
    const int nblk = N / 32, kb = item / nblk, nb = item % nblk, k0 = 64 * kb, n0 = 32 * nb;
    const int d0 = UPPERM ? (n0 < DFF ? 256 * (n0 >> 7) + (n0 & 127) : 256 * ((n0 - DFF) >> 7) + 128 + ((n0 - DFF) & 127)) : n0;
    f32x4 ld[8]; float scv[8];
#pragma unroll
    for (int i = 0; i < 8; ++i) { const int kk = 8 * i + (lane >> 3); ld[i] = *(const f32x4*)(W + (size_t)(k0 + kk) * N + n0 + 4 * (lane & 7)); scv[i] = g ? g[k0 + kk] : 1.f; }
#pragma unroll
    for (int i = 0; i < 8; ++i) { const int kk = 8 * i + (lane >> 3); LAS float* d = scr + kk * 33 + 4 * (lane & 7);
        d[0] = ld[i][0] * scv[i]; d[1] = ld[i][1] * scv[i]; d[2] = ld[i][2] * scv[i]; d[3] = ld[i][3] * scv[i]; }
    LDS_WAIT(); asm volatile("" ::: "memory");
    const int c = lane & 7;
#pragma unroll
    for (int j = 0; j < 4; ++j) { const int n = (lane >> 3) + 8 * j; const LAS float* s = scr + (8 * c) * 33 + n;
        v4u o; o.x = pk2(s[0 * 33], s[1 * 33]); o.y = pk2(s[2 * 33], s[3 * 33]); o.z = pk2(s[4 * 33], s[5 * 33]); o.w = pk2(s[6 * 33], s[7 * 33]);
        *(GAS v4u*)(WT + (size_t)(d0 + n) * K + k0 + 8 * c) = o; }
    LDS_WAIT(); asm volatile("" ::: "memory");
}
__device__ __forceinline__ void sincos_d(double x, double& s, double& c) {
    const double n = __builtin_rint(x * 0.15915494309189535);
    double r = __builtin_fma(-n, 6.283185307179586, x); r = __builtin_fma(-n, 2.4492935982947064e-16, r);
    const double r2 = r * r; double ts = r, tc = 1.0; s = r; c = 1.0;
#pragma unroll
    for (int k = 1; k <= 14; ++k) { tc = -tc * r2 / (double)((2 * k - 1) * (2 * k)); c += tc; ts = -ts * r2 / (double)((2 * k) * (2 * k + 1)); s += ts; }
}

typedef float f32x16 __attribute__((ext_vector_type(16)));
typedef short bf16x8v __attribute__((ext_vector_type(8), may_alias));
typedef short s16x4 __attribute__((ext_vector_type(4), may_alias));
struct Seg { int smp, b, cu, nrows, row0, pos0; };
__device__ __forceinline__ Seg seg_prompt(int u) { Seg s; s.smp = 0; s.b = u >> 4; s.cu = u & 15; s.nrows = 128; s.row0 = s.b * SEQ + s.cu * 128; s.pos0 = s.cu * 128; return s; }
__device__ __forceinline__ Seg seg_sample(int b) { Seg s; s.smp = 1; s.b = b; s.cu = 0; s.nrows = ST; s.row0 = MP + b * ST; s.pos0 = SEQ; return s; }
struct MixCtx { const bf16* z; bf16* mix; float* out; int l; const float* rope; const bf16* gwb; const bf16* wpT; };
__device__ __forceinline__ int offK(int key, int ch) { return key * 128 + ((ch ^ ((key >> 1) & 7)) << 4); }
__device__ __forceinline__ int offV(int key, int ch) { return key * 128 + ((ch ^ (((key >> 1) & 1) << 2)) << 4); }
__device__ __forceinline__ s16x4 lds_tr(const LAS unsigned char* p) { return __builtin_bit_cast(s16x4, __builtin_amdgcn_ds_read_tr16_b64_v4i16((LAS s16x4*)p)); }
__device__ __forceinline__ unsigned cvtpk(float lo, float hi) { unsigned r; asm volatile("v_cvt_pk_bf16_f32 %0, %1, %2" : "=v"(r) : "v"(lo), "v"(hi)); return r; }
__device__ __forceinline__ v4u pack8(const f32x4 a, const f32x4 c) { v4u w; w.x = cvtpk(a[0], a[1]); w.y = cvtpk(a[2], a[3]); w.z = cvtpk(c[0], c[1]); w.w = cvtpk(c[2], c[3]); return w; }
__device__ __forceinline__ void st8f(float* o, v4u val) { *(f32x4*)o = (f32x4){bflo(val.x), bfhi(val.x), bflo(val.y), bfhi(val.y)}; *(f32x4*)(o + 4) = (f32x4){bflo(val.z), bfhi(val.z), bflo(val.w), bfhi(val.w)}; }

__device__ __forceinline__ void attn_unit(const MixCtx& C, const Seg& sg, const float* sinkp, const float* ck, const float* cv, LAS unsigned char* L, int wave) {
    const int lane = lane_id(), tid = wave * 64 + lane, l = C.l, b = sg.b, cu = sg.cu;
    const bf16* z = C.z; float* out = C.out;
    if (sg.smp) {
        {
            float x1[3], x2[3], cs[3], sn[3];
#pragma unroll
            for (int k = 0; k < 3; ++k) { const int it = tid + 512 * k, t = it / 48, pr = it % 48, c1 = (pr >> 3) * 64 + (pr & 7);
                const bf16* zr = z + ZOFF(sg.row0 + t, 0) + (c1 >> 8) * ZBLK - (size_t)(c1 & ~255); x1[k] = bf2f(zr[c1]); x2[k] = bf2f(zr[c1 + 8]);
                cs[k] = C.rope[(size_t)((SEQ + t) * 8 + (pr & 7)) * 2]; sn[k] = C.rope[(size_t)((SEQ + t) * 8 + (pr & 7)) * 2 + 1]; }
#pragma unroll
            for (int k = 0; k < 3; ++k) { const int it = tid + 512 * k, t = it / 48, pr = it % 48, c1 = (pr >> 3) * 64 + (pr & 7);
                bf16* zr = (bf16*)z + ZOFF(sg.row0 + t, 0) + (c1 >> 8) * ZBLK - (size_t)(c1 & ~255);
                zr[c1] = (bf16)f2bf(x1[k] * cs[k] - x2[k] * sn[k]); zr[c1 + 8] = (bf16)f2bf(x2[k] * cs[k] + x1[k] * sn[k]); }
        }
        asm volatile("s_waitcnt vmcnt(0)" ::: "memory"); __syncthreads();
    }
    const int hq = sg.smp ? (wave & 3) : ((wave >> 2) * 2 + ((wave >> 1) & 1)), hk = hq >> 1, half = wave & 1, h = lane >> 5, r32 = lane & 31;
    const int ntask = sg.smp ? (wave < 4 ? 1 : 0) : 2;
    bf16x8v qfa[2][4];
#pragma unroll
    for (int qc = 0; qc < 2; ++qc) if (qc < ntask) { const int qrow = sg.smp ? sg.row0 + r32 : sg.row0 + qc * 64 + half * 32 + r32;
#pragma unroll
        for (int s = 0; s < 4; ++s) qfa[qc][s] = *(const bf16x8v*)(z + ZOFF(qrow, ZQ) + hq * 64 + 16 * s + 8 * h); }
    const int nk = sg.smp ? (WIN + ST) : 256;
    if (!sg.smp) {
        v4u kvv[16];
#pragma unroll
        for (int k = 0; k < 16; ++k) { const int it = tid + 512 * k, c32 = it & 31, kk = it >> 5; kvv[k] = *(const v4u*)(z + ZOFF(sg.row0 - 128 + ((cu == 0 && kk < 128) ? 128 : kk), ZK) + c32 * 8); }
#pragma unroll
        for (int k = 0; k < 16; ++k) { const int it = tid + 512 * k, c32 = it & 31, kk = it >> 5, kv = c32 >> 4, hk = (c32 >> 3) & 1, ch = c32 & 7;
            if (cu == 0 && kk < 128) continue;
            const v4u val = kvv[k];
            const int off = kv == 0 ? hk * 32768 + offK(kk, ch) : 65536 + hk * 32768 + offV(kk, ch);
            *(LAS v4u*)(L + off) = val;
            if (cu == 15 && kk >= 128) st8f(out + (kv == 0 ? O_PK : O_PV) + (size_t)((b * 2 + l) * WIN + (kk - 128)) * 128 + hk * 64 + ch * 8, val); }
    } else {
    {
        f32x4 ca[8][2];
#pragma unroll
        for (int k = 0; k < 8; ++k) { const int it = tid + 512 * k, c32 = it & 31, kk = it >> 5, kv = c32 >> 4, hk = (c32 >> 3) & 1, ch = c32 & 7;
            const float* src = (kv == 0 ? ck : cv) + (size_t)((b * 2 + l) * WIN + kk) * 128 + hk * 64 + 8 * ch; ca[k][0] = *(const f32x4*)src; ca[k][1] = *(const f32x4*)(src + 4); }
#pragma unroll
        for (int k = 0; k < 8; ++k) { const int it = tid + 512 * k, c32 = it & 31, kk = it >> 5, kv = c32 >> 4, hk = (c32 >> 3) & 1, ch = c32 & 7;
            *(LAS v4u*)(L + (kv == 0 ? hk * 32768 + offK(kk, ch) : 65536 + hk * 32768 + offV(kk, ch))) = pack8(ca[k][0], ca[k][1]); }
    }
    for (int it = tid + 4096; it < nk * 32; it += 512) {
        const int c32 = it & 31, kk = it >> 5, kv = c32 >> 4, hk = (c32 >> 3) & 1, ch = c32 & 7;
        v4u val;
        if (sg.smp && kk < WIN) { const float* src = (kv == 0 ? ck : cv) + (size_t)((b * 2 + l) * WIN + kk) * 128 + hk * 64 + 8 * ch; val = pack8(*(const f32x4*)src, *(const f32x4*)(src + 4)); }
        else { if (!sg.smp && cu == 0 && kk < 128) continue;
            const int row = sg.smp ? sg.row0 + (kk - WIN) : sg.row0 - 128 + kk; val = *(const v4u*)(z + ZOFF(row, ZK) + c32 * 8); }
        const int off = kv == 0 ? hk * 32768 + offK(kk, ch) : 65536 + hk * 32768 + offV(kk, ch);
        *(LAS v4u*)(L + off) = val;
        if (sg.smp) { if (kk >= WIN) st8f(out + (kv == 0 ? O_SK : O_SV) + (size_t)((b * 2 + l) * ST + (kk - WIN)) * 128 + hk * 64 + ch * 8, val); }
        else if (cu == 15 && kk >= 128) st8f(out + (kv == 0 ? O_PK : O_PV) + (size_t)((b * 2 + l) * WIN + (kk - 128)) * 128 + hk * 64 + ch * 8, val);
    }
    }
    __syncthreads();
    const float sk = sinkp[l * 4 + hq];
    const LAS unsigned char* Kimg = L + hk * 32768; const LAS unsigned char* Vimg = L + 65536 + hk * 32768;
    constexpr float C1 = 0.125f * 1.4426950408889634f, LOG2E = 1.4426950408889634f;
#pragma unroll
    for (int qc = 0; qc < 2; ++qc) { if (qc < ntask) {
        const int qrow = sg.smp ? sg.row0 + r32 : sg.row0 + qc * 64 + half * 32 + r32, keybase = sg.smp ? 0 : qc * 64;
        const int Tstart = (!sg.smp && cu == 0) ? (qc == 0 ? 4 : 2) : 0, Tend = sg.smp ? 5 : 6;
        bf16x8v qf[4];
#pragma unroll
        for (int s = 0; s < 4; ++s) qf[s] = qfa[qc][s];
        f32x16 S[6]; float mx = -3.0e38f;
#pragma unroll
        for (int T = 0; T < 6; ++T) {
            if (T >= Tstart && T < Tend) {
                f32x16 a = {0.f, 0.f, 0.f, 0.f, 0.f, 0.f, 0.f, 0.f, 0.f, 0.f, 0.f, 0.f, 0.f, 0.f, 0.f, 0.f};
                const int key = keybase + 32 * T + r32;
#pragma unroll
                for (int s = 0; s < 4; ++s) { const bf16x8v kf = *(const LAS bf16x8v*)(Kimg + offK(key, 2 * s + h)); a = __builtin_amdgcn_mfma_f32_32x32x16_bf16(kf, qf[s], a, 0, 0, 0); }
                S[T] = a;
#pragma unroll
                for (int r = 0; r < 16; ++r) mx = fmaxf(mx, a[r]);
            } else {
#pragma unroll
                for (int r = 0; r < 16; ++r) S[T][r] = -3.0e38f;
            }
        }
        mx = fmaxf(mx, __shfl_xor(mx, 32));
        const float m = fmaxf(mx * 0.125f, sk), mb = m * LOG2E;
        float sum = 0.f;
#pragma unroll
        for (int T = 0; T < 6; ++T)
#pragma unroll
            for (int r = 0; r < 16; ++r) { const float p = __builtin_amdgcn_exp2f(S[T][r] * C1 - mb); S[T][r] = p; sum += p; }
        sum += __shfl_xor(sum, 32);
        const float inv = __builtin_amdgcn_rcpf(sum + __builtin_amdgcn_exp2f((sk - m) * LOG2E));
        f32x16 O[2];
#pragma unroll
        for (int dt = 0; dt < 2; ++dt)
#pragma unroll
            for (int r = 0; r < 16; ++r) O[dt][r] = 0.f;
        const int q4 = (lane & 15) >> 2, p4 = lane & 3, g2 = (lane >> 4) & 1;
#pragma unroll
        for (int T = 0; T < 6; ++T) {
            if (T >= Tstart && T < Tend) {
#pragma unroll
                for (int s = 0; s < 2; ++s) {
                    v4u pw; pw.x = cvtpk(S[T][8 * s + 0], S[T][8 * s + 1]); pw.y = cvtpk(S[T][8 * s + 2], S[T][8 * s + 3]); pw.z = cvtpk(S[T][8 * s + 4], S[T][8 * s + 5]); pw.w = cvtpk(S[T][8 * s + 6], S[T][8 * s + 7]);
                    const bf16x8v pf = __builtin_bit_cast(bf16x8v, pw);
                    const int k0 = keybase + 32 * T + 16 * s + 4 * h + q4;
#pragma unroll
                    for (int dt = 0; dt < 2; ++dt) {
                        const int chn = 2 * g2 + (p4 >> 1) + 4 * dt;
                        const s16x4 lo = lds_tr(Vimg + offV(k0, chn) + 8 * (p4 & 1)), hi = lds_tr(Vimg + offV(k0 + 8, chn) + 8 * (p4 & 1));
                        const bf16x8v vf = (bf16x8v){lo[0], lo[1], lo[2], lo[3], hi[0], hi[1], hi[2], hi[3]};
                        O[dt] = __builtin_amdgcn_mfma_f32_32x32x16_bf16(vf, pf, O[dt], 0, 0, 0);
                    }
                }
            }
        }
        bf16* op = C.mix + (size_t)qrow * DM + hq * 64 + 4 * h;
#pragma unroll
        for (int dt = 0; dt < 2; ++dt)
#pragma unroll
            for (int rg = 0; rg < 4; ++rg) { v2u w; w.x = cvtpk(O[dt][4 * rg] * inv, O[dt][4 * rg + 1] * inv); w.y = cvtpk(O[dt][4 * rg + 2] * inv, O[dt][4 * rg + 3] * inv);
                *(v2u*)(op + 32 * dt + 8 * rg) = w; }
    } }
    __syncthreads();
}
__device__ __forceinline__ int offGv(int j, int byte) { return 512 * j + ((((byte >> 6) ^ (j & 3))) << 6) + (byte & 63); }
__device__ __forceinline__ void gmlp_unit(const MixCtx& C, const Seg& sg, const float* lng, const float* lnb, const float* gb, LAS unsigned char* L, int wave) {
    const int lane = lane_id(), l = C.l, r0 = sg.row0, nrows = sg.nrows;
    const bf16* z = C.z;
    {
        const f32x4 gg = *(const f32x4*)(lng + l * 256 + 4 * lane), bb = *(const f32x4*)(lnb + l * 256 + 4 * lane);
        v2u raws[16];
#pragma unroll
        for (int jj = 0; jj < 16; ++jj) { const int j = wave + 8 * jj; if (j < nrows) raws[jj] = *(const v2u*)(z + ZOFF(r0 + j, ZGV) + 4 * lane); else raws[jj] = (v2u){0u, 0u}; }
        float xv[16][4], s1[16], s2[16];
#pragma unroll
        for (int jj = 0; jj < 16; ++jj) { const v2u raw = raws[jj];
            xv[jj][0] = gelu_t(bflo(raw.x)); xv[jj][1] = gelu_t(bfhi(raw.x)); xv[jj][2] = gelu_t(bflo(raw.y)); xv[jj][3] = gelu_t(bfhi(raw.y));
            s1[jj] = (xv[jj][0] + xv[jj][1]) + (xv[jj][2] + xv[jj][3]);
            s2[jj] = (xv[jj][0] * xv[jj][0] + xv[jj][1] * xv[jj][1]) + (xv[jj][2] * xv[jj][2] + xv[jj][3] * xv[jj][3]); }
#pragma unroll
        for (int o = 1; o < 64; o <<= 1) {
#pragma unroll
            for (int jj = 0; jj < 16; ++jj) { s1[jj] += __shfl_xor(s1[jj], o); s2[jj] += __shfl_xor(s2[jj], o); } }
#pragma unroll
        for (int jj = 0; jj < 16; ++jj) { const int j = wave + 8 * jj; if (j < nrows) {
            const float mean = s1[jj] * (1.f / 256.f), var = s2[jj] * (1.f / 256.f) - mean * mean;
            const float rstd = __builtin_amdgcn_rsqf(var + EPS);
            const f32x4 y = (f32x4){(xv[jj][0] - mean) * rstd * gg[0] + bb[0], (xv[jj][1] - mean) * rstd * gg[1] + bb[1], (xv[jj][2] - mean) * rstd * gg[2] + bb[2], (xv[jj][3] - mean) * rstd * gg[3] + bb[3]};
            v2u w; w.x = cvtpk(y[0], y[1]); w.y = cvtpk(y[2], y[3]);
            *(LAS v2u*)(L + offGv(j, 8 * lane)) = w;
            if (sg.smp) *(f32x4*)(C.out + O_SG + (size_t)((sg.b * 2 + l) * ST + j) * 256 + 4 * lane) = y;
        } }
    }
    const int g = wave >> 1, dt = wave & 1, h = lane >> 5, r32 = lane & 31, q4 = (lane & 15) >> 2, p4 = lane & 3, g2 = (lane >> 4) & 1;
    const int nks = nrows >> 4, nit = nrows >> 5;
    const bf16* wg = C.gwb + (size_t)((l * 4 + g) * 128) * 128;
    bf16x8v bfr[8][4];
    if (nrows == 128) {
#pragma unroll
        for (int ks = 0; ks < 8; ++ks)
#pragma unroll
            for (int it = 0; it < 4; ++it) if (!(it < 2 && ks >= 4)) bfr[ks][it] = *(const bf16x8v*)(wg + (size_t)(32 * it + r32) * 128 + 16 * ks + 8 * h);
    }
    __syncthreads();
    f32x16 acc[4];
#pragma unroll
    for (int it = 0; it < 4; ++it)
#pragma unroll
        for (int r = 0; r < 16; ++r) acc[it][r] = 0.f;
    v2u uraw[4][4]; float bsv[4];
#pragma unroll
    for (int it = 0; it < 4; ++it) if (it < nit) { const int i = 32 * it + r32; bsv[it] = gb[(l * 4 + g) * 128 + i];
        const bf16* up = z + ZOFF(r0 + i, ZGU) + 64 * g + 32 * dt + 4 * h;
#pragma unroll
        for (int rg = 0; rg < 4; ++rg) uraw[it][rg] = *(const v2u*)(up + 8 * rg); }
    const int cb = 2 * (64 * g + 32 * dt + 16 * g2 + 4 * p4);
#pragma unroll
    for (int ks = 0; ks < 8; ++ks) {
        if (ks < nks) {
            const int j0 = 16 * ks + 8 * h;
            const s16x4 lo = lds_tr(L + offGv(j0 + q4, cb)), hi = lds_tr(L + offGv(j0 + 4 + q4, cb));
            const bf16x8v af = (bf16x8v){lo[0], lo[1], lo[2], lo[3], hi[0], hi[1], hi[2], hi[3]};
#pragma unroll
            for (int it = 0; it < 4; ++it) { if ((it < 2 && ks >= 4) || it >= nit) continue;
                bf16x8v bf; if (nrows == 128) bf = bfr[ks][it]; else bf = *(const bf16x8v*)(wg + (size_t)(32 * it + r32) * 128 + 16 * ks + 8 * h);
                acc[it] = __builtin_amdgcn_mfma_f32_32x32x16_bf16(af, bf, acc[it], 0, 0, 0); }
        }
    }
#pragma unroll
    for (int it = 0; it < 4; ++it) {
        if (it < nit) {
            const int i = 32 * it + r32; const float bs = bsv[it];
            bf16* op = C.mix + (size_t)(r0 + i) * DM + 512 + 64 * g + 32 * dt + 4 * h;
#pragma unroll
            for (int rg = 0; rg < 4; ++rg) { const v2u ur = uraw[it][rg];
                v2u w; w.x = cvtpk(gelu_t(bflo(ur.x)) * (acc[it][4 * rg] + bs), gelu_t(bfhi(ur.x)) * (acc[it][4 * rg + 1] + bs)); w.y = cvtpk(gelu_t(bflo(ur.y)) * (acc[it][4 * rg + 2] + bs), gelu_t(bfhi(ur.y)) * (acc[it][4 * rg + 3] + bs));
                *(v2u*)(op + 8 * rg) = w; }
        }
    }
    __syncthreads();
}
__device__ __forceinline__ int offPl(int t, int ch) { return 512 * t + ((((ch >> 3) ^ (t & 15))) << 4) + 2 * (ch & 7); }
__device__ __forceinline__ void pool_unit(const MixCtx& C, const Seg& sg, const float* spool, const float* psc, LAS unsigned char* L, int wave) {
    const int lane = lane_id(), tid = wave * 64 + lane, l = C.l, r0 = sg.row0, nrows = sg.nrows;
    const bf16* z = C.z;
    LAS unsigned char* Pim = L; LAS unsigned char* Qim = L + 73728;
    const bool st_out = sg.smp || sg.cu == 15;
    {
        const int nit = (nrows + 15) * 32; const bool zhalo = !sg.smp && sg.cu > 0;
        v4u pv[9];
#pragma unroll
        for (int k = 0; k < 9; ++k) { const int it = tid + 512 * k, itc = it < nit ? it : nit - 1, e = itc >> 5, c = itc & 31;
            pv[k] = *(const v4u*)(z + ZOFF(r0 + ((e >= 15 || zhalo) ? e - 15 : 0), ZPI) + 8 * c); }
#pragma unroll
        for (int k = 0; k < 9; ++k) { const int it = tid + 512 * k; if (it < nit) { const int e = it >> 5, c = it & 31; v4u val = pv[k];
            if (!(e >= 15 || zhalo)) { if (sg.smp) { const float* src = spool + (size_t)((sg.b * 2 + l) * 15 + e) * 256 + 8 * c; val = pack8(*(const f32x4*)src, *(const f32x4*)(src + 4)); } else val = (v4u){0u, 0u, 0u, 0u}; }
            *(LAS v4u*)(Pim + e * 512 + c * 16) = val;
            if (st_out && e >= nrows) st8f(C.out + (sg.smp ? O_SP : O_PP) + (size_t)((sg.b * 2 + l) * 15 + (e - nrows)) * 256 + 8 * c, val); } }
    }
    __syncthreads();
    {
        const int ch = tid & 255, t0 = (tid >> 8) * 64, gq = ch >> 6, win = 2 << gq;
        if (t0 < nrows) {
            const int tend = (t0 + 64) < nrows ? (t0 + 64) : nrows;
            const LAS bf16* P = (const LAS bf16*)Pim;
            float sum = 0.f;
            for (int j = 1; j < win; ++j) sum += bf2f(P[(15 + t0 - j) * 256 + ch]);
            for (int t = t0; t < tend; t += 8) {
                float xs[8], xo[8];
#pragma unroll
                for (int i = 0; i < 8; ++i) { xs[i] = bf2f(P[(15 + t + i) * 256 + ch]); xo[i] = bf2f(P[(15 + t + i - (win - 1)) * 256 + ch]); }
#pragma unroll
                for (int i = 0; i < 8; ++i) { sum += xs[i];
                    const int pos = sg.pos0 + t + i; const int cnt = (pos + 1) < win ? (pos + 1) : win;
                    *(LAS bf16*)(Qim + offPl(t + i, ch)) = (bf16)f2bf(sum * __builtin_amdgcn_rcpf((float)cnt) - xs[i]);
                    sum -= xo[i]; }
            }
        }
    }
    __syncthreads();
    const int g = wave >> 1, dt = wave & 1, h = lane >> 5, r32 = lane & 31;
    bf16x8v af[4]; f32x4 s4v[4];
#pragma unroll
    for (int ks = 0; ks < 4; ++ks) af[ks] = *(const bf16x8v*)(C.wpT + (size_t)((l * 4 + g) * 64 + 32 * dt + r32) * 64 + 16 * ks + 8 * h);
#pragma unroll
    for (int rg = 0; rg < 4; ++rg) s4v[rg] = *(const f32x4*)(psc + l * 256 + 64 * g + 32 * dt + 4 * h + 8 * rg);
    for (int tt = 0; tt < (nrows >> 5); ++tt) {
        f32x16 a = {0.f, 0.f, 0.f, 0.f, 0.f, 0.f, 0.f, 0.f, 0.f, 0.f, 0.f, 0.f, 0.f, 0.f, 0.f, 0.f};
        const int t = 32 * tt + r32;
#pragma unroll
        for (int ks = 0; ks < 4; ++ks) { const bf16x8v bf = *(const LAS bf16x8v*)(Qim + 512 * t + (((8 * g + 2 * ks + h) ^ (t & 15)) << 4)); a = __builtin_amdgcn_mfma_f32_32x32x16_bf16(af[ks], bf, a, 0, 0, 0); }
        bf16* op = C.mix + (size_t)(r0 + t) * DM + 768 + 64 * g + 32 * dt + 4 * h;
#pragma unroll
        for (int rg = 0; rg < 4; ++rg) { const f32x4 s4 = s4v[rg];
            v2u w; w.x = cvtpk(a[4 * rg] * s4[0], a[4 * rg + 1] * s4[1]); w.y = cvtpk(a[4 * rg + 2] * s4[2], a[4 * rg + 3] * s4[3]); *(v2u*)(op + 8 * rg) = w; }
    }
    __syncthreads();
}
__device__ __forceinline__ void conv_unit(const MixCtx& C, const Seg& sg, const float* convw, const float* sconv, int wave) {
    const int lane = lane_id(), tid = wave * 64 + lane, l = C.l;
    const int r0 = sg.row0, cg = tid & 31, t0 = (tid >> 5) * 8, ch = 8 * cg;
    if (t0 >= sg.nrows) return;
    const bf16* z = C.z;
    float w[3][8];
#pragma unroll
    for (int j = 0; j < 3; ++j) { const f32x4 a = *(const f32x4*)(convw + (l * 3 + j) * 256 + ch), c = *(const f32x4*)(convw + (l * 3 + j) * 256 + ch + 4);
        w[j][0] = a[0]; w[j][1] = a[1]; w[j][2] = a[2]; w[j][3] = a[3]; w[j][4] = c[0]; w[j][5] = c[1]; w[j][6] = c[2]; w[j][7] = c[3]; }
    float m1[8], m2[8];
#pragma unroll
    for (int e = 0; e < 8; ++e) { m1[e] = 0.f; m2[e] = 0.f; }
    const bool st_out = sg.smp || sg.cu == 15;
    const bool zhalo = !sg.smp && sg.cu > 0;
    v4u ra[10], rc[10], rb[8];
#pragma unroll
    for (int i = -2; i < 8; ++i) { const int t = t0 + i; const int rr = r0 + ((t >= 0 || zhalo) ? t : 0); ra[i + 2] = *(const v4u*)(z + ZOFF(rr, ZCC) + ch); rc[i + 2] = *(const v4u*)(z + ZOFF(rr, ZCH) + ch); }
#pragma unroll
    for (int i = 0; i < 8; ++i) rb[i] = *(const v4u*)(z + ZOFF(r0 + t0 + i, ZCB) + ch);
#pragma unroll
    for (int i = -2; i < 8; ++i) {
        const int t = t0 + i; float m0[8];
        if (t >= 0 || zhalo) { const v4u a = ra[i + 2], c = rc[i + 2];
            m0[0] = bflo(a.x) * bflo(c.x); m0[1] = bfhi(a.x) * bfhi(c.x); m0[2] = bflo(a.y) * bflo(c.y); m0[3] = bfhi(a.y) * bfhi(c.y); m0[4] = bflo(a.z) * bflo(c.z); m0[5] = bfhi(a.z) * bfhi(c.z); m0[6] = bflo(a.w) * bflo(c.w); m0[7] = bfhi(a.w) * bfhi(c.w); }
        else if (sg.smp) { const float* sp = sconv + (size_t)((sg.b * 2 + l) * 2 + (t + 2)) * 256 + ch; const f32x4 a = *(const f32x4*)sp, c = *(const f32x4*)(sp + 4);
            m0[0] = a[0]; m0[1] = a[1]; m0[2] = a[2]; m0[3] = a[3]; m0[4] = c[0]; m0[5] = c[1]; m0[6] = c[2]; m0[7] = c[3]; }
        else {
#pragma unroll
            for (int e = 0; e < 8; ++e) m0[e] = 0.f; }
        if (i >= 0) {
            const v4u cbv = rb[i >= 0 ? i : 0];
            const float cbf[8] = {bflo(cbv.x), bfhi(cbv.x), bflo(cbv.y), bfhi(cbv.y), bflo(cbv.z), bfhi(cbv.z), bflo(cbv.w), bfhi(cbv.w)};
            float o[8];
#pragma unroll
            for (int e = 0; e < 8; ++e) o[e] = cbf[e] * (w[0][e] * m2[e] + w[1][e] * m1[e] + w[2][e] * m0[e]);
            v4u wv; wv.x = cvtpk(o[0], o[1]); wv.y = cvtpk(o[2], o[3]); wv.z = cvtpk(o[4], o[5]); wv.w = cvtpk(o[6], o[7]);
            *(v4u*)(C.mix + (size_t)(r0 + t) * DM + 256 + ch) = wv;
            if (st_out && t >= sg.nrows - 2) { float* o2 = C.out + (sg.smp ? O_SC : O_PC) + (size_t)((sg.b * 2 + l) * 2 + (t - (sg.nrows - 2))) * 256 + ch;
                *(f32x4*)o2 = (f32x4){m0[0], m0[1], m0[2], m0[3]}; *(f32x4*)(o2 + 4) = (f32x4){m0[4], m0[5], m0[6], m0[7]}; }
        }
#pragma unroll
        for (int e = 0; e < 8; ++e) { m2[e] = m1[e]; m1[e] = m0[e]; }
    }
}

template <int NT, int NCH>
__device__ __forceinline__ void sg_accumulate(const bf16* A, int lda, const bf16* Bt, int K, int t0, int n0, int kc0, LAS unsigned char* Lw, int lane, f32x16 (&acc)[NT]) {
    constexpr int NR = NT * 32 + 32, NI = NR / 8;
    const int lr = lane >> 3, lc = lane & 7, h = lane >> 5, r32 = lane & 31;
#pragma unroll
    for (int t = 0; t < NT; ++t)
#pragma unroll
        for (int r = 0; r < 16; ++r) acc[t][r] = 0.f;
    const bf16* rowp[NI];
#pragma unroll
    for (int i = 0; i < NI; ++i) { const int r = 8 * i + lr; rowp[i] = (i < 4 ? Bt + (size_t)(n0 + r) * K : A + (size_t)(t0 + r - 32) * lda) + kc0 * 64 + 8 * lc; }
    v4u buf[2][NI];
#pragma unroll
    for (int i = 0; i < NI; ++i) buf[0][i] = *(const v4u*)rowp[i];
#pragma unroll
    for (int c = 0; c < NCH; ++c) {
        if (c + 1 < NCH) {
#pragma unroll
            for (int i = 0; i < NI; ++i) buf[(c + 1) & 1][i] = *(const v4u*)(rowp[i] + 64 * (c + 1)); }
#pragma unroll
        for (int i = 0; i < NI; ++i) *(LAS v4u*)(Lw + (8 * i + lr) * 144 + lc * 16) = buf[c & 1][i];
#pragma unroll
        for (int s4 = 0; s4 < 4; ++s4) { const bf16x8v bw = *(const LAS bf16x8v*)(Lw + r32 * 144 + 32 * s4 + 16 * h);
#pragma unroll
            for (int t = 0; t < NT; ++t) { const bf16x8v ba = *(const LAS bf16x8v*)(Lw + (32 + 32 * t + r32) * 144 + 32 * s4 + 16 * h); acc[t] = __builtin_amdgcn_mfma_f32_32x32x16_bf16(bw, ba, acc[t], 0, 0, 0); } }
    }
}
template <int NT, int NSUM>
__device__ __forceinline__ f32x4 sg_reduce(const f32x16 (&a)[NT], int wave, LAS unsigned char* L, int lane, int rt, int rg, int src0, bool valid) {
    __syncthreads();
#pragma unroll
    for (int t = 0; t < NT; ++t)
#pragma unroll
        for (int g4 = 0; g4 < 4; ++g4) *(LAS f32x4*)(L + (size_t)((((wave * NT + t) * 4 + g4) * 64 + lane) * 16)) = (f32x4){a[t][4 * g4], a[t][4 * g4 + 1], a[t][4 * g4 + 2], a[t][4 * g4 + 3]};
    __syncthreads();
    f32x4 s = (f32x4){0.f, 0.f, 0.f, 0.f};
    if (valid) {
#pragma unroll
        for (int w = 0; w < NSUM; ++w) s += *(const LAS f32x4*)(L + (size_t)(((((src0 + w) * NT + rt) * 4 + rg) * 64 + lane) * 16)); }
    return s;
}
constexpr int SG_STG = 14336;
constexpr int SG_AUX = 8 * SG_STG;

template <int NTT>
__device__ __forceinline__ void sres_epilogue(bool valid, f32x4 v, int t0, int n0, int cb, int rt, int rg, int lane, int tid, bf16* xbs, float* ssq_out, LAS float* red) {
    const int h = lane >> 5, r32 = lane & 31;
    if (valid) { const int token = t0 + 32 * rt + r32, chn = n0 + 8 * rg + 4 * h;
        const v2u r = *(const v2u*)(xbs + (size_t)token * DM + chn);
        v2u w; w.x = cvtpk(bflo(r.x) + v[0], bfhi(r.x) + v[1]); w.y = cvtpk(bflo(r.y) + v[2], bfhi(r.y) + v[3]); *(v2u*)(xbs + (size_t)token * DM + chn) = w;
        const float q0 = bflo(w.x), q1 = bfhi(w.x), q2 = bflo(w.y), q3 = bfhi(w.y);
        float sq = (q0 * q0 + q1 * q1) + (q2 * q2 + q3 * q3); sq += __shfl_xor(sq, 32);
        if (h == 0) red[(rt * 4 + rg) * 32 + r32] = sq; }
    __syncthreads();
    if (tid < 32 * NTT) { const int rt2 = tid >> 5, r = tid & 31; ssq_out[cb * 256 + t0 + tid] = (red[(rt2 * 4 + 0) * 32 + r] + red[(rt2 * 4 + 1) * 32 + r]) + (red[(rt2 * 4 + 2) * 32 + r] + red[(rt2 * 4 + 3) * 32 + r]); }
    __syncthreads();
}

__global__ void __launch_bounds__(512, 2) trunk_fwd(Args args) {
    extern __shared__ __attribute__((aligned(16))) unsigned char lds[];
    LAS unsigned char* L = (LAS unsigned char*)lds;
    volatile LAS unsigned* MISC = (volatile LAS unsigned*)(L + MISC_OFF);
    unsigned* ctl = (unsigned*)(AWS() + WS_CTL);
    const int wave = __builtin_amdgcn_readfirstlane(threadIdx.x >> 6);
    if (threadIdx.x < 32) MISC[threadIdx.x] = 0u;
    __syncthreads();
    XcdBarrier bar = xcd_barrier_post(ctl + CW_BAR, MISC + 8);
#define DERIVE() int bx = blockIdx.x, G = gridDim.x; asm volatile("" : "+s"(bx), "+s"(G)); const int lane = lane_id(), tid = wave * 64 + lane, gw = bx * 8 + wave, NGW = G * 8; (void)lane; (void)gw; (void)NGW; unsigned char* ws = AWS(); float* out = AOUT(); \
    float* rope = (float*)(ws + WS_ROPE); bf16* gwb = (bf16*)(ws + WS_ROPE + 262144); bf16* wpT = (bf16*)(ws + WS_ROPE + 524288); float* ssqSA = (float*)(ws + WS_ROPE + 655360); float* ssqSB = (float*)(ws + WS_ROPE + 720896); (void)gwb; (void)wpT; (void)ssqSA; (void)ssqSB; bf16* Win_t = (bf16*)(ws + WS_WIN); bf16* Wout_t = (bf16*)(ws + WS_WOUT); bf16* Wup_t = (bf16*)(ws + WS_WUP); bf16* Wdn_t = (bf16*)(ws + WS_WDN); \
    float* ssqA = (float*)(ws + WS_SSQA); float* ssqB = (float*)(ws + WS_SSQB); float* headf = (float*)(ws + WS_HEAD); float* tailf = (float*)(ws + WS_TAIL); bf16* xb = (bf16*)(ws + WS_XB); bf16* zb = (bf16*)(ws + WS_Z); \
    bf16* mixb = (bf16*)(ws + WS_MIX); bf16* actb = (bf16*)(ws + WS_ACT); bf16* upsb = (bf16*)(ws + WS_UPS); LAS float* aux = (LAS float*)(L + AUX_OFF); \
    (void)rope; (void)Win_t; (void)Wout_t; (void)Wup_t; (void)Wdn_t; (void)ssqA; (void)ssqB; (void)headf; (void)tailf; (void)xb; (void)zb; (void)mixb; (void)actb; (void)upsb; (void)aux; (void)out;
#define IN(k) true
#define SEAM(k) xcd_barrier(bar, wave)

    if (IN(0)) { DERIVE()
        LAS float* scr = (LAS float*)(L + wave * 16384);
        constexpr int I_IN = (DM / 64) * (NPROJ / 32), I_OUT = (DM / 64) * (DM / 32), I_UP = (DM / 64) * (NUP / 32), I_DN = (DFF / 64) * (DM / 32), I_L = I_IN + I_OUT + I_UP + I_DN;
        for (int it = gw; it < 2 * I_L; it += NGW) {
            const int l = it / I_L; int r = it % I_L;
            if (r < I_IN) { p0_transpose_item<false>(AIN(I_WIN) + (size_t)l * DM * NPROJ, DM, NPROJ, AIN(I_GMIX) + l * DM, Win_t + (size_t)l * NPROJ * DM, scr, r, lane); continue; } r -= I_IN;
            if (r < I_OUT) { p0_transpose_item<false>(AIN(I_WOUT) + (size_t)l * DM * DM, DM, DM, nullptr, Wout_t + (size_t)l * DM * DM, scr, r, lane); continue; } r -= I_OUT;
            if (r < I_UP) { p0_transpose_item<true>(AIN(I_WUP) + (size_t)l * DM * NUP, DM, NUP, AIN(I_GFFN) + l * DM, Wup_t + (size_t)l * NUP * DM, scr, r, lane); continue; } r -= I_UP;
            p0_transpose_item<false>(AIN(I_WDN) + (size_t)l * DFF * DM, DFF, DM, nullptr, Wdn_t + (size_t)l * DM * DFF, scr, r, lane);
        }
        for (int m0 = gw; m0 < MT; m0 += 4 * NGW) {
            f32x4 v[4][4];
#pragma unroll
            for (int r = 0; r < 4; ++r) { const int m = m0 + r * NGW; if (m < MT) { const float* xr = m < MP ? AIN(I_XP) + (size_t)m * DM : AIN(I_XS) + (size_t)(m - MP) * DM; const GAS f32x4* x4 = (const GAS f32x4*)xr + lane;
#pragma unroll
                for (int j = 0; j < 4; ++j) v[r][j] = x4[64 * j]; } }
#pragma unroll
            for (int r = 0; r < 4; ++r) { const int m = m0 + r * NGW; if (m < MT) { float s = 0.f;
                GAS unsigned long long* o8 = (GAS unsigned long long*)(xb + (size_t)m * DM) + lane;
#pragma unroll
                for (int j = 0; j < 4; ++j) { const unsigned w0 = pk2(v[r][j].x, v[r][j].y), w1 = pk2(v[r][j].z, v[r][j].w); o8[64 * j] = (unsigned long long)w0 | ((unsigned long long)w1 << 32);
                    s += (bflo(w0) * bflo(w0) + bfhi(w0) * bfhi(w0)) + (bflo(w1) * bflo(w1) + bfhi(w1) * bfhi(w1)); }
                s = wave_sum(s);
                if (m < MP) { if (lane < 4) ssqA[(size_t)lane * MT + m] = lane == 0 ? s : 0.f; } else if (lane == 0) ssqSA[m - MP] = s; } }
        }
        for (int i = bx * 512 + tid; i < (SEQ + ST) * 8; i += G * 512) {
            const int pos = i >> 3, f = i & 7;
            const double invf[8] = {1.0, 0.19392274474868576, 0.03760603093086393, 0.007292664737217109, 0.001414213562373095, 0.0002742481756762073, 5.318295896944988e-05, 1.031338537721246e-05};
            double fr = 1.0;
#pragma unroll
            for (int j = 0; j < 8; ++j) fr = (f == j) ? invf[j] : fr;
            const float ang = (float)pos * (float)fr; double s, c; sincos_d((double)ang, s, c);
            rope[2 * i] = (float)c; rope[2 * i + 1] = (float)s;
        }
        for (int i = bx * 512 + tid; i < 2 * 4 * 128 * 128; i += G * 512) { const int j = i & 127, ii = (i >> 7) & 127; gwb[i] = (bf16)((j >> 6) <= (ii >> 6) ? f2bf(AIN(I_GW)[i]) : 0u); }
        for (int i = bx * 512 + tid; i < 2 * 4 * 64 * 64; i += G * 512) { const int c = i & 63, d = (i >> 6) & 63, lg = i >> 12; wpT[i] = (bf16)f2bf(AIN(I_PW)[(size_t)(lg * 64 + c) * 64 + d]); }
        SEAM(0);
    }

    for (int l = 0; l < 2; ++l) {
        const int pb = 1 + 6 * l;
        if (IN(pb)) { DERIVE()
            pg8::Gemm g{xb, Win_t + (size_t)l * NPROJ * DM, MP, NPROJ, DM, DM}; pg8::StaticOrder S; S.init(MP, NPROJ, G, bx);
            pg8::EpiRow<1> E{{}, zb, 256, ssqA, l == 0 ? 1 : 4, aux, rope, L + AUX_OFF + 16384};
            pg8::gemm_phase<pg8::EpiRow<1>, false, true>(L, g, S, E, wave);
            {
                LAS float* rsl = (LAS float*)(L + SG_AUX); const int np = l == 0 ? 1 : 32;
                for (int su = bx; su < 256; su += G) { const int t0 = (su & 3) * 64, n0 = (su >> 2) * 32;
                    if (tid < 64) { float sq;
                        if (np == 1) sq = ssqSA[t0 + tid];
                        else { float pv[32];
#pragma unroll
                            for (int p = 0; p < 32; ++p) pv[p] = ssqSA[p * 256 + t0 + tid];
                            sq = 0.f;
#pragma unroll
                            for (int p = 0; p < 32; ++p) sq += pv[p]; }
                        rsl[tid] = __builtin_amdgcn_rsqf(sq * (1.0f / DM) + EPS); }
                    f32x16 acc2[2]; sg_accumulate<2, 2>(xb + (size_t)MP * DM, DM, Win_t + (size_t)l * NPROJ * DM, DM, t0, n0, 2 * wave, L + wave * SG_STG, lane, acc2);
                    const int rt = wave >> 2, rg = wave & 3;
                    const f32x4 v = sg_reduce<2, 8>(acc2, wave, L, lane, rt, rg, 0, true);
                    const int tl = 32 * rt + (lane & 31); const float rs = rsl[tl];
                    v2u w; w.x = cvtpk(v[0] * rs, v[1] * rs); w.y = cvtpk(v[2] * rs, v[3] * rs);
                    *(v2u*)(zb + ZOFF(MP + t0 + tl, n0) + 8 * rg + 4 * (lane >> 5)) = w;
                    __syncthreads(); }
            }
            SEAM(pb);
        }
        if (IN(pb + 1)) { DERIVE()
            MixCtx C{zb, mixb, out, l, rope, gwb, wpT};
            asm volatile(".rept 51\n\ts_nop 0\n\t.endr" ::: "memory");
            for (int u = bx; u < 256 + 4 * SB; u += G) {
                if (u < 256) { const Seg sg = seg_prompt(G == 256 ? (u & 7) * 32 + (u >> 3) : u);
                    attn_unit(C, sg, AIN(I_SINK), AIN(I_CK), AIN(I_CV), L, wave);
                    gmlp_unit(C, sg, AIN(I_LNG), AIN(I_LNB), AIN(I_GB), L, wave);
                    pool_unit(C, sg, AIN(I_SPOOL), AIN(I_PSC), L, wave);
                    conv_unit(C, sg, AIN(I_CONVW), AIN(I_SCONV), wave);
                } else { const Seg sg = seg_sample((u - 256) >> 2); const int kind = (u - 256) & 3;
                    if (kind == 0) conv_unit(C, sg, AIN(I_CONVW), AIN(I_SCONV), wave);
                    else if (kind == 1) attn_unit(C, sg, AIN(I_SINK), AIN(I_CK), AIN(I_CV), L, wave);
                    else if (kind == 2) gmlp_unit(C, sg, AIN(I_LNG), AIN(I_LNB), AIN(I_GB), L, wave);
                    else pool_unit(C, sg, AIN(I_SPOOL), AIN(I_PSC), L, wave);
                }
            }
            SEAM(pb + 1);
        }
        if (IN(pb + 2)) { DERIVE()
            pg8::Gemm g{mixb, Wout_t + (size_t)l * DM * DM, MP, DM, DM, DM}; pg8::StaticOrder S; S.init(MP, DM, G, bx);
            pg8::EpiRes E{{}, xb, xb, ssqB, aux, L + AUX_OFF + 16384};
            pg8::gemm_phase<pg8::EpiRes, true, true>(L, g, S, E, wave);
            {
                LAS float* red = (LAS float*)(L + SG_AUX);
                for (int su = bx; su < 256; su += G) { const int t0 = (su & 7) * 32, cb = su >> 3, n0 = cb * 32;
                    f32x16 acc1[1]; sg_accumulate<1, 2>(mixb + (size_t)MP * DM, DM, Wout_t + (size_t)l * DM * DM, DM, t0, n0, 2 * wave, L + wave * SG_STG, lane, acc1);
                    const bool valid = wave < 4; const f32x4 v = sg_reduce<1, 8>(acc1, wave, L, lane, 0, wave & 3, 0, valid);
                    sres_epilogue<1>(valid, v, t0, n0, cb, 0, wave & 3, lane, tid, xb + (size_t)MP * DM, ssqSB, red); }
            }
            SEAM(pb + 2);
        }
        if (IN(pb + 3)) { DERIVE()
            pg8::Gemm g{xb, Wup_t + (size_t)l * NUP * DM, MP, NUP, DM, DM}; pg8::StaticOrder S; S.init(MP, NUP, G, bx);
            pg8::EpiUpAct E{{}, actb, ssqB, 4, aux, (LAS f32x4*)(L + AUX_OFF + 8192), (LAS float*)(L + AUX_OFF + 10240), AIN(I_FCW) + (size_t)l * 3 * NUP, headf, tailf, out + O_PF + (size_t)l * 2 * NUP, L + AUX_OFF + 16384};
            pg8::gemm_phase<pg8::EpiUpAct, true, true, true>(L, g, S, E, wave);
            if (4 * G >= 4 * (NUP / 32))
            {
                LAS float* rsl = (LAS float*)(L + SG_AUX);
                const int team = wave >> 1, j2 = wave & 1, su_ = bx + G * team; const bool act_ = su_ < 4 * (NUP / 32);
                const int su = act_ ? su_ : bx;
                const int t0 = (su & 3) * 64, n0 = (su >> 2) * 32;
                f32x16 acc2[2];
                if (j2 == 0) { float pv[32], sq = 0.f;
#pragma unroll
                    for (int p = 0; p < 32; ++p) pv[p] = ssqSB[p * 256 + t0 + lane];
#pragma unroll
                    for (int p = 0; p < 32; ++p) sq += pv[p];
                    rsl[team * 64 + lane] = __builtin_amdgcn_rsqf(sq * (1.0f / DM) + EPS); }
                sg_accumulate<2, 8>(xb + (size_t)MP * DM, DM, Wup_t + (size_t)l * NUP * DM, DM, t0, n0, 8 * j2, L + wave * SG_STG, lane, acc2);
                __syncthreads();
#pragma unroll
                for (int t = 0; t < 2; ++t)
#pragma unroll
                    for (int g4 = 0; g4 < 4; ++g4) *(LAS f32x4*)(L + (size_t)((((wave * 2 + t) * 4 + g4) * 64 + lane) * 16)) = (f32x4){acc2[t][4 * g4], acc2[t][4 * g4 + 1], acc2[t][4 * g4 + 2], acc2[t][4 * g4 + 3]};
                __syncthreads();
                if (act_) {
                    const int tl = 32 * j2 + (lane & 31); const float rs = rsl[team * 64 + tl];
#pragma unroll
                    for (int rg = 0; rg < 4; ++rg) {
                        const f32x4 v = *(const LAS f32x4*)(L + (size_t)(((((team * 2 + 0) * 2 + j2) * 4 + rg) * 64 + lane) * 16)) + *(const LAS f32x4*)(L + (size_t)(((((team * 2 + 1) * 2 + j2) * 4 + rg) * 64 + lane) * 16));
                        v2u w; w.x = cvtpk(v[0] * rs, v[1] * rs); w.y = cvtpk(v[2] * rs, v[3] * rs);
                        *(v2u*)(upsb + (size_t)(t0 + tl) * NUP + n0 + 8 * rg + 4 * (lane >> 5)) = w; }
                }
                __syncthreads();
            }
            else
            {
                LAS float* rsl = (LAS float*)(L + SG_AUX);
                for (int su = bx; su < 4 * (NUP / 32); su += G) { const int t0 = (su & 3) * 64, n0 = (su >> 2) * 32;
                    if (tid < 64) { float pv[32], sq = 0.f;
#pragma unroll
                        for (int p = 0; p < 32; ++p) pv[p] = ssqSB[p * 256 + t0 + tid];
#pragma unroll
                        for (int p = 0; p < 32; ++p) sq += pv[p];
                        rsl[tid] = __builtin_amdgcn_rsqf(sq * (1.0f / DM) + EPS); }
                    f32x16 acc2[2]; sg_accumulate<2, 2>(xb + (size_t)MP * DM, DM, Wup_t + (size_t)l * NUP * DM, DM, t0, n0, 2 * wave, L + wave * SG_STG, lane, acc2);
                    const int rt = wave >> 2, rg = wave & 3;
                    const f32x4 v = sg_reduce<2, 8>(acc2, wave, L, lane, rt, rg, 0, true);
                    const int tl = 32 * rt + (lane & 31); const float rs = rsl[tl];
                    v2u w; w.x = cvtpk(v[0] * rs, v[1] * rs); w.y = cvtpk(v[2] * rs, v[3] * rs);
                    *(v2u*)(upsb + (size_t)(t0 + tl) * NUP + n0 + 8 * rg + 4 * (lane >> 5)) = w;
                    __syncthreads(); }
            }
            SEAM(pb + 3);
        }
        if (IN(5)) { DERIVE()
            constexpr int NCG = DFF / 8, NFIX = 112 * NCG, NSMP = MS * NCG;
            const float* fcw = AIN(I_FCW) + (size_t)l * 3 * NUP;
            for (int task = bx * 512 + tid; task < NFIX + NSMP; task += G * 512) {
                const bool smp = task >= NFIX; const int tk = smp ? task - NFIX : task; const int q = tk / NCG, ch = (tk % NCG) * 8;
                const int ic = 256 * (ch >> 7) + (ch & 127);
                float wg[3][8], wv[3][8];
#pragma unroll
                for (int j = 0; j < 3; ++j) { const f32x4 a0 = *(const f32x4*)(fcw + j * NUP + ch), a1 = *(const f32x4*)(fcw + j * NUP + ch + 4), c0 = *(const f32x4*)(fcw + j * NUP + DFF + ch), c1 = *(const f32x4*)(fcw + j * NUP + DFF + ch + 4);
#pragma unroll
                    for (int e = 0; e < 4; ++e) { wg[j][e] = a0[e]; wg[j][4 + e] = a1[e]; wv[j][e] = c0[e]; wv[j][4 + e] = c1[e]; } }
                if (!smp) {
                    float gh[2][8], vh[2][8];
                    const int pm = (q / 7) * 8 + (q % 7) + 1;
#pragma unroll
                    for (int j = 0; j < 2; ++j) { const float* tp = tailf + (size_t)((pm - 1) * 2 + j) * NUP + ic; const f32x4 a0 = *(const f32x4*)tp, a1 = *(const f32x4*)(tp + 4), c0 = *(const f32x4*)(tp + 128), c1 = *(const f32x4*)(tp + 132);
#pragma unroll
                        for (int e = 0; e < 4; ++e) { gh[j][e] = a0[e]; gh[j][4 + e] = a1[e]; vh[j][e] = c0[e]; vh[j][4 + e] = c1[e]; } }
#pragma unroll
                    for (int r = 0; r < 2; ++r) { const float* hp = headf + (size_t)(pm * 2 + r) * NUP + ic; const f32x4 a0 = *(const f32x4*)hp, a1 = *(const f32x4*)(hp + 4), c0 = *(const f32x4*)(hp + 128), c1 = *(const f32x4*)(hp + 132);
                        float gg[8] = {a0[0], a0[1], a0[2], a0[3], a1[0], a1[1], a1[2], a1[3]}, vv[8] = {c0[0], c0[1], c0[2], c0[3], c1[0], c1[1], c1[2], c1[3]}; float o[8];
#pragma unroll
                        for (int e = 0; e < 8; ++e) { const float Gc = wg[0][e] * gh[0][e] + wg[1][e] * gh[1][e] + wg[2][e] * gg[e]; const float Vc = wv[0][e] * vh[0][e] + wv[1][e] * vh[1][e] + wv[2][e] * vv[e];
                            o[e] = silu_f(Gc) * Vc; gh[0][e] = gh[1][e]; gh[1][e] = gg[e]; vh[0][e] = vh[1][e]; vh[1][e] = vv[e]; }
                        v4u w; w.x = pk2(o[0], o[1]); w.y = pk2(o[2], o[3]); w.z = pk2(o[4], o[5]); w.w = pk2(o[6], o[7]);
                        *(v4u*)(actb + (size_t)(pm * 256 + r) * DFF + ch) = w; }
                } else {
                    const int b = q >> 5, r = q & 31;
                    float xg[3][8], xv[3][8];
#pragma unroll
                    for (int j = 0; j < 3; ++j) { const int rr = r - 2 + j;
                        if (rr >= 0) { const bf16* rp = upsb + (size_t)(b * ST + rr) * NUP + ic; const v4u a = *(const v4u*)rp, c = *(const v4u*)(rp + 128);
                            xg[j][0] = bflo(a.x); xg[j][1] = bfhi(a.x); xg[j][2] = bflo(a.y); xg[j][3] = bfhi(a.y); xg[j][4] = bflo(a.z); xg[j][5] = bfhi(a.z); xg[j][6] = bflo(a.w); xg[j][7] = bfhi(a.w);
                            xv[j][0] = bflo(c.x); xv[j][1] = bfhi(c.x); xv[j][2] = bflo(c.y); xv[j][3] = bfhi(c.y); xv[j][4] = bflo(c.z); xv[j][5] = bfhi(c.z); xv[j][6] = bflo(c.w); xv[j][7] = bfhi(c.w); }
                        else { const float* st = AIN(I_SFFN) + (size_t)((b * 2 + l) * 2 + (rr + 2)) * NUP; const f32x4 a0 = *(const f32x4*)(st + ch), a1 = *(const f32x4*)(st + ch + 4), c0 = *(const f32x4*)(st + DFF + ch), c1 = *(const f32x4*)(st + DFF + ch + 4);
#pragma unroll
                            for (int e = 0; e < 4; ++e) { xg[j][e] = a0[e]; xg[j][4 + e] = a1[e]; xv[j][e] = c0[e]; xv[j][4 + e] = c1[e]; } } }
                    float o[8];
#pragma unroll
                    for (int e = 0; e < 8; ++e) { const float Gc = wg[0][e] * xg[0][e] + wg[1][e] * xg[1][e] + wg[2][e] * xg[2][e]; const float Vc = wv[0][e] * xv[0][e] + wv[1][e] * xv[1][e] + wv[2][e] * xv[2][e]; o[e] = silu_f(Gc) * Vc; }
                    v4u w; w.x = pk2(o[0], o[1]); w.y = pk2(o[2], o[3]); w.z = pk2(o[4], o[5]); w.w = pk2(o[6], o[7]);
                    *(v4u*)(actb + (size_t)(MP + b * ST + r) * DFF + ch) = w;
                    if (r >= ST - 2) { float* sp = out + O_SF + (size_t)((b * 2 + l) * 2 + (r - (ST - 2))) * NUP + ch;
                        *(f32x4*)sp = (f32x4){xg[2][0], xg[2][1], xg[2][2], xg[2][3]}; *(f32x4*)(sp + 4) = (f32x4){xg[2][4], xg[2][5], xg[2][6], xg[2][7]};
                        *(f32x4*)(sp + DFF) = (f32x4){xv[2][0], xv[2][1], xv[2][2], xv[2][3]}; *(f32x4*)(sp + DFF + 4) = (f32x4){xv[2][4], xv[2][5], xv[2][6], xv[2][7]}; }
                }
            }
            SEAM(pb + 4);
        }
        if (IN(pb + 5)) { DERIVE()
            pg8::Gemm g{actb, Wdn_t + (size_t)l * DM * DFF, MP, DM, DFF, DFF}; pg8::StaticOrder S; S.init(MP, DM, G, bx);
            if (l == 1 && G == 256) { pg8::EpiFinal Ef{{}, xb, out, AIN(I_GFIN), ssqB + (size_t)8 * MT, ctl + CW_PANEL, aux, L + AUX_OFF + 8192}; pg8::gemm_phase<pg8::EpiFinal, true, true>(L, g, S, Ef, wave); }
            else { pg8::EpiRes E{{}, xb, xb, ssqA, aux, L + AUX_OFF + 16384}; pg8::gemm_phase<pg8::EpiRes, true, true>(L, g, S, E, wave); }
            {
                LAS float* red = (LAS float*)(L + SG_AUX);
                for (int su = bx; su < 256; su += G) { const int t0 = (su & 7) * 32, cb = su >> 3, n0 = cb * 32;
                    f32x16 acc1[1];
                    if (wave < 4) sg_accumulate<1, 6>(actb + (size_t)MP * DFF, DFF, Wdn_t + (size_t)l * DM * DFF, DFF, t0, n0, 6 * wave, L + wave * SG_STG, lane, acc1);
                    else sg_accumulate<1, 5>(actb + (size_t)MP * DFF, DFF, Wdn_t + (size_t)l * DM * DFF, DFF, t0, n0, 24 + 5 * (wave - 4), L + wave * SG_STG, lane, acc1);
                    const bool valid = wave < 4; const f32x4 v = sg_reduce<1, 8>(acc1, wave, L, lane, 0, wave & 3, 0, valid);
                    sres_epilogue<1>(valid, v, t0, n0, cb, 0, wave & 3, lane, tid, xb + (size_t)MP * DM, ssqSA, red); }
            }
            SEAM(pb + 5);
        }
    }
    if (IN(13)) { DERIVE()
        const float* gf = AIN(I_GFIN);
        for (int m = (G == 256 ? MP : 0) + gw; m < MT; m += NGW) {
            const GAS v2u* xin = (const GAS v2u*)(xb + (size_t)m * DM) + lane; GAS f32x4* y4 = (GAS f32x4*)(out + (size_t)m * DM) + lane; const f32x4* g4 = (const f32x4*)gf + lane;
            float s = 0.f; if (m < MP) { if (lane < 4) s = ssqA[(size_t)lane * MT + m]; } else if (lane < 32) s = ssqSA[lane * 256 + (m - MP)];
            v2u wv[4]; f32x4 gv4[4];
#pragma unroll
            for (int j = 0; j < 4; ++j) { wv[j] = xin[64 * j]; gv4[j] = g4[64 * j]; }
            s = wave_sum(s); const float rs = __builtin_amdgcn_rsqf(s * (1.0f / DM) + EPS);
#pragma unroll
            for (int j = 0; j < 4; ++j) { const v2u w = wv[j]; const f32x4 gg = gv4[j]; y4[64 * j] = (f32x4){bflo(w.x) * rs * gg.x, bfhi(w.x) * rs * gg.y, bflo(w.y) * rs * gg.z, bfhi(w.y) * rs * gg.w}; }
        }
    }
#undef IN
#undef SEAM
}

extern "C" void kernel_launch(void* const* d_in, const int* in_sizes, int n_in, void* d_out, int out_size, void* d_ws, size_t ws_size, hipStream_t stream) {
    static int grid = 0;
    if (grid == 0) {
        if (n_in != 23 || in_sizes[0] != MP * DM || (size_t)out_size != O_END || ws_size < WS_END) { fprintf(stderr, "kernel_launch: unexpected shapes: n_in %d in0 %d out %d ws %zu\n", n_in, n_in > 0 ? in_sizes[0] : -1, out_size, ws_size); grid = -1; return; }
        int dev = 0, cus = 0;
        if (hipGetDevice(&dev) != hipSuccess || hipDeviceGetAttribute(&cus, hipDeviceAttributeMultiprocessorCount, dev) != hipSuccess) { grid = -1; return; }
        if (hipFuncSetAttribute((const void*)trunk_fwd, hipFuncAttributeMaxDynamicSharedMemorySize, LDS_BYTES) != hipSuccess) { fprintf(stderr, "kernel_launch: hipFuncSetAttribute failed\n"); grid = -1; return; }
        int per_cu = 0;
        if (hipOccupancyMaxActiveBlocksPerMultiprocessor(&per_cu, (const void*)trunk_fwd, 512, LDS_BYTES) != hipSuccess || per_cu < 1) fprintf(stderr, "kernel_launch: occupancy query reports %d\n", per_cu);
        (void)hipGetLastError();
        grid = cus;
    }
    if (grid < 0) return;
    (void)hipMemsetAsync((char*)d_ws + WS_CTL, 0, CTL_ZERO_BYTES, stream);
    Args a{};
    for (int i = 0; i < 23; ++i) a.in[i] = (const float*)d_in[i];
    a.out = (float*)d_out; a.ws = (unsigned char*)d_ws;
    hipLaunchKernelGGL(trunk_fwd, dim3(grid), dim3(512), LDS_BYTES, stream, a);
}
```
